# Optimizing an MI355X kernel written in HIP

```python
import jax, jax.numpy as jnp
from jax import lax
import numpy as np

D_MODEL = 2048
BATCH = 2
SEQ = 4096
DEPTH = 1

CTX_LEN = 256
GRID_W = 64
N_ADALN = 6
EPS = 1e-6
N_HEADS = 8
KV_HEADS = 2
GROUP = N_HEADS // KV_HEADS
HEAD_DIM = 128
AXIS_DIM = HEAD_DIM // 2
ROPE_THETA = 10000.0
Q_BLOCK = 128
ATT_WIDTH = N_HEADS * HEAD_DIM
ATT_SCALE = HEAD_DIM ** -0.5
M_HEADS = 4
M_DK = 128
M_DV = 256
M_CHUNK = 128
M_WIDTH = M_HEADS * M_DV
FORGET_BIAS = 3.0
MIX_WIDTH = ATT_WIDTH + M_WIDTH
IN_WIDTHS = (ATT_WIDTH, KV_HEADS * HEAD_DIM, KV_HEADS * HEAD_DIM,
             M_HEADS * M_DK, M_HEADS * M_DK, M_WIDTH, M_WIDTH, 2 * M_HEADS, 2 * M_HEADS)
IN_COLS = sum(IN_WIDTHS)
N_EXPERTS = 32
TOP_K = 4
D_FF = D_MODEL
SWIGLU_LIMIT = 7.0
SWIGLU_ALPHA = 1.702
MOE_BLOCK = 128

kernel_name = 'hymba_style_gqa_mlstm_moe_dit_layer'


def rmsnorm(x, g):
    xf = x.astype(jnp.float32)
    y = xf * lax.rsqrt(jnp.mean(xf * xf, axis=-1, keepdims=True) + EPS)
    return (y * g).astype(x.dtype)


def modulate(h, shift, scale):
    return h * (1 + scale) + shift


def split_columns(p):
    points = np.cumsum(IN_WIDTHS)[:-1].tolist()
    return jnp.split(p, points, axis=-1)


def axial_rope_tables(rows):
    row = jnp.repeat(jnp.arange(rows, dtype=jnp.float32), GRID_W)
    col = jnp.tile(jnp.arange(GRID_W, dtype=jnp.float32), rows)
    inv = ROPE_THETA ** (-jnp.arange(0, AXIS_DIM, 2, dtype=jnp.float32) / AXIS_DIM)
    ang = jnp.concatenate([row[:, None] * inv, col[:, None] * inv], axis=-1)
    return jnp.cos(ang), jnp.sin(ang)


def apply_rope(x, cos, sin):
    xf = x.astype(jnp.float32).reshape(x.shape[:-1] + (HEAD_DIM // 2, 2))
    x1, x2 = xf[..., 0], xf[..., 1]
    cs, sn = cos[:, None, :], sin[:, None, :]
    out = jnp.stack([x1 * cs - x2 * sn, x1 * sn + x2 * cs], axis=-1)
    return out.reshape(x.shape).astype(x.dtype)


def attention_qkv(aq, ak, av, g_q, g_k):
    B, T = aq.shape[0], aq.shape[1]
    q = rmsnorm(aq.reshape(B, T, N_HEADS, HEAD_DIM), g_q)
    k = rmsnorm(ak.reshape(B, T, KV_HEADS, HEAD_DIM), g_k)
    v = av.reshape(B, T, KV_HEADS, HEAD_DIM)
    return q, k, v


def dense_attention(q, k, v):
    s = jnp.einsum('bqkgd,bskd->bkgqs', q, k).astype(jnp.float32) * ATT_SCALE
    p = jax.nn.softmax(s, axis=-1).astype(v.dtype)
    return jnp.einsum('bkgqs,bskd->bqkgd', p, v)


def latent_attention(q, k_all, v_all):
    B, N = q.shape[0], q.shape[1]
    nb = N // Q_BLOCK
    qb = q.reshape(B, nb, Q_BLOCK, KV_HEADS, GROUP, HEAD_DIM).swapaxes(0, 1)
    o = lax.map(lambda qblk: dense_attention(qblk, k_all, v_all), qb)
    return o.swapaxes(0, 1).reshape(B, N, ATT_WIDTH)


def mlstm_heads(mq, mk, mv, mi, mf):
    B, T = mq.shape[0], mq.shape[1]
    q = mq.astype(jnp.float32).reshape(B, T, M_HEADS, M_DK).transpose(0, 2, 1, 3)
    k = mk.astype(jnp.float32).reshape(B, T, M_HEADS, M_DK).transpose(0, 2, 1, 3) * (M_DK ** -0.5)
    v = mv.astype(jnp.float32).reshape(B, T, M_HEADS, M_DV).transpose(0, 2, 1, 3)
    i_pre = mi.astype(jnp.float32).reshape(B, T, 2, M_HEADS).transpose(2, 0, 3, 1)
    logf = jax.nn.log_sigmoid(mf.astype(jnp.float32).reshape(B, T, 2, M_HEADS).transpose(2, 0, 3, 1))
    return q, k, v, i_pre, logf


def mlstm_chunkwise(q, k, v, i_pre, logf, state):
    B, H, T = q.shape[0], q.shape[1], q.shape[2]
    nc = T // M_CHUNK

    def to_chunks(a):
        return jnp.moveaxis(a.reshape((B, H, nc, M_CHUNK) + a.shape[3:]), 2, 0)

    tril = jnp.tril(jnp.ones((M_CHUNK, M_CHUNK), dtype=bool))

    def step(carry, inp):
        C, n, m = carry
        qc, kc, vc, ic, fc = inp
        b = jnp.cumsum(fc, axis=-1)
        d = jnp.where(tril, b[..., :, None] - b[..., None, :] + ic[..., None, :], -jnp.inf)
        inter = b + m[..., None]
        m_t = jnp.maximum(inter, jnp.max(d, axis=-1))
        w_intra = jnp.exp(d - m_t[..., None])
        w_inter = jnp.exp(inter - m_t)
        s = jnp.einsum('bhtd,bhsd->bhts', qc, kc) * w_intra
        num = jnp.einsum('bhts,bhsv->bhtv', s, vc) + w_inter[..., None] * jnp.einsum('bhvd,bhtd->bhtv', C, qc)
        den = jnp.sum(s, axis=-1) + w_inter * jnp.einsum('bhd,bhtd->bht', n, qc)
        h = num / jnp.maximum(jnp.abs(den), jnp.exp(-m_t))[..., None]
        b_last = b[..., -1]
        g = b_last[..., None] - b + ic
        m_new = jnp.maximum(b_last + m, jnp.max(g, axis=-1))
        w_state = jnp.exp(g - m_new[..., None])
        decay = jnp.exp(b_last + m - m_new)
        C = decay[..., None, None] * C + jnp.einsum('bhs,bhsv,bhsd->bhvd', w_state, vc, kc)
        n = decay[..., None] * n + jnp.einsum('bhs,bhsd->bhd', w_state, kc)
        return (C, n, m_new), h

    state, h = lax.scan(step, state, (to_chunks(q), to_chunks(k), to_chunks(v), to_chunks(i_pre), to_chunks(logf)))
    return state, jnp.moveaxis(h, 0, 2).reshape(B, H, T, M_DV)


def flip_t(a):
    return jnp.flip(a, axis=2)


def mlstm_output(h, o_pre, g_mlstm):
    B, H, T = h.shape[0], h.shape[1], h.shape[2]
    hn = h * lax.rsqrt(jnp.mean(h * h, axis=-1, keepdims=True) + EPS)
    hn = hn.transpose(0, 2, 1, 3).reshape(B, T, M_WIDTH) * g_mlstm
    return (jax.nn.sigmoid(o_pre.astype(jnp.float32)) * hn).astype(o_pre.dtype)


def mlstm_bidirectional(lat, cx, g_mlstm, with_ctx):
    mq_l, mk_l, mv_l, mo_l, mi_l, mf_l = lat
    mq_c, mk_c, mv_c, mo_c, mi_c, mf_c = cx
    ql, kl, vl, il, fl = mlstm_heads(mq_l, mk_l, mv_l, mi_l, mf_l)
    qc, kc, vc, ic, fc = mlstm_heads(mq_c, mk_c, mv_c, mi_c, mf_c)
    B = ql.shape[0]
    zero = (jnp.zeros((B, M_HEADS, M_DV, M_DK), jnp.float32),
            jnp.zeros((B, M_HEADS, M_DK), jnp.float32),
            jnp.zeros((B, M_HEADS), jnp.float32))
    st_f, hc_f = mlstm_chunkwise(qc, kc, vc, ic[0], fc[0], zero)
    st_b, hc_b = mlstm_chunkwise(flip_t(qc), flip_t(kc), flip_t(vc), flip_t(ic[1]), flip_t(fc[1]), zero)
    _, hl_f = mlstm_chunkwise(ql, kl, vl, il[0], fl[0], st_f)
    _, hl_b = mlstm_chunkwise(flip_t(ql), flip_t(kl), flip_t(vl), flip_t(il[1]), flip_t(fl[1]), st_b)
    out_lat = mlstm_output(hl_f + flip_t(hl_b), mo_l, g_mlstm)
    out_ctx = mlstm_output(hc_f + flip_t(hc_b), mo_c, g_mlstm) if with_ctx else None
    return out_lat, out_ctx


def mixer_group(h_lat, h_ctx, w_in, b_in, g_q, g_k, g_mlstm, cos, sin, with_ctx):
    lat = split_columns(h_lat @ w_in + b_in)
    cx = split_columns(h_ctx @ w_in + b_in)
    q_l, k_l, v_l = attention_qkv(lat[0], lat[1], lat[2], g_q, g_k)
    q_l = apply_rope(q_l, cos, sin)
    k_l = apply_rope(k_l, cos, sin)
    q_c, k_c, v_c = attention_qkv(cx[0], cx[1], cx[2], g_q, g_k)
    a_lat = latent_attention(q_l, jnp.concatenate([k_l, k_c], axis=1), jnp.concatenate([v_l, v_c], axis=1))
    m_lat, m_ctx = mlstm_bidirectional(lat[3:], cx[3:], g_mlstm, with_ctx)
    y_lat = jnp.concatenate([a_lat, m_lat], axis=-1)
    y_ctx = None
    if with_ctx:
        B, C = q_c.shape[0], q_c.shape[1]
        a_ctx = dense_attention(q_c.reshape(B, C, KV_HEADS, GROUP, HEAD_DIM), k_c, v_c).reshape(B, C, ATT_WIDTH)
        y_ctx = jnp.concatenate([a_ctx, m_ctx], axis=-1)
    return y_lat, y_ctx


def moe(h, w_router, b_router, w1, b1, w2, b2):
    T, D = h.shape
    logits = (h @ w_router).astype(jnp.float32) + b_router
    top_val, top_idx = lax.top_k(logits, TOP_K)
    weights = jax.nn.softmax(top_val, axis=-1)
    A = T * TOP_K
    e_flat = top_idx.reshape(A)
    tok_flat = jnp.repeat(jnp.arange(T, dtype=jnp.int32), TOP_K)
    w_flat = weights.reshape(A)
    order = jnp.argsort(e_flat)
    e_sorted, tok_sorted, w_sorted = e_flat[order], tok_flat[order], w_flat[order]
    counts = jnp.zeros((N_EXPERTS,), jnp.int32).at[e_flat].add(1)
    padded = (counts + MOE_BLOCK - 1) // MOE_BLOCK * MOE_BLOCK
    start = jnp.cumsum(counts) - counts
    pstart = jnp.cumsum(padded) - padded
    pend = pstart + padded
    dest = pstart[e_sorted] + jnp.arange(A, dtype=jnp.int32) - start[e_sorted]
    nblk = -(-A // MOE_BLOCK) + N_EXPERTS
    P = nblk * MOE_BLOCK
    row_tok = jnp.full((P,), T, jnp.int32).at[dest].set(tok_sorted)
    row_w = jnp.zeros((P,), jnp.float32).at[dest].set(w_sorted)
    blk_start = jnp.arange(nblk, dtype=jnp.int32) * MOE_BLOCK
    blk_expert = jnp.minimum(jnp.sum(pend[None, :] <= blk_start[:, None], axis=1), N_EXPERTS - 1)
    h_pad = jnp.concatenate([h, jnp.zeros((1, D), h.dtype)], axis=0)

    def block(args):
        e, toks, wts = args
        xb = h_pad[toks]
        gu = xb @ w1[e] + b1[e]
        gate, up = gu[:, :D_FF], gu[:, D_FF:]
        gate = jnp.minimum(gate, SWIGLU_LIMIT)
        up = jnp.clip(up, -SWIGLU_LIMIT, SWIGLU_LIMIT)
        glu = gate * jax.nn.sigmoid(SWIGLU_ALPHA * gate)
        y = ((up + 1) * glu) @ w2[e] + b2[e]
        return y * wts[:, None].astype(y.dtype)

    y = lax.map(block, (blk_expert, row_tok.reshape(nblk, MOE_BLOCK), row_w.reshape(nblk, MOE_BLOCK)))
    out = jnp.zeros((T + 1, D), h.dtype).at[row_tok].add(y.reshape(P, D).astype(h.dtype))
    return out[:T]


def setup_inputs(seed: int = 0) -> dict:
    key = jax.random.key(seed)
    ks = jax.random.split(key, 22)
    nrm = jax.random.normal
    f32 = jnp.float32
    b_in = 0.02 * nrm(ks[8], (DEPTH, IN_COLS), f32)
    b_in = b_in.at[:, IN_COLS - 2 * M_HEADS:].add(FORGET_BIAS)
    return {
        'x': nrm(ks[0], (BATCH, SEQ, D_MODEL), f32),
        'c': nrm(ks[1], (BATCH, D_MODEL), f32),
        'ctx': nrm(ks[2], (BATCH, CTX_LEN, D_MODEL), f32),
        'c_ctx': nrm(ks[3], (D_MODEL,), f32),
        'w_mod': nrm(ks[4], (DEPTH, D_MODEL, N_ADALN * D_MODEL), f32) * (0.5 * D_MODEL ** -0.5),
        'b_mod': 0.02 * nrm(ks[5], (DEPTH, N_ADALN * D_MODEL), f32),
        'g_norm1': 1.0 + 0.05 * nrm(ks[6], (DEPTH, D_MODEL), f32),
        'w_in': nrm(ks[7], (DEPTH, D_MODEL, IN_COLS), f32) * (D_MODEL ** -0.5),
        'b_in': b_in,
        'g_q': 1.0 + 0.05 * nrm(ks[9], (DEPTH, HEAD_DIM), f32),
        'g_k': 1.0 + 0.05 * nrm(ks[10], (DEPTH, HEAD_DIM), f32),
        'g_mlstm': 1.0 + 0.05 * nrm(ks[11], (DEPTH, M_WIDTH), f32),
        'w_out': nrm(ks[12], (DEPTH, MIX_WIDTH, D_MODEL), f32) * (MIX_WIDTH ** -0.5),
        'g_norm2': 1.0 + 0.05 * nrm(ks[13], (DEPTH, D_MODEL), f32),
        'w_router': nrm(ks[14], (DEPTH, D_MODEL, N_EXPERTS), f32) * (D_MODEL ** -0.5),
        'b_router': 0.01 * nrm(ks[15], (DEPTH, N_EXPERTS), f32),
        'w1': nrm(ks[16], (DEPTH, N_EXPERTS, D_MODEL, 2 * D_FF), f32) * (D_MODEL ** -0.5),
        'b1': 0.02 * nrm(ks[17], (DEPTH, N_EXPERTS, 2 * D_FF), f32),
        'w2': nrm(ks[18], (DEPTH, N_EXPERTS, D_FF, D_MODEL), f32) * (D_FF ** -0.5),
        'b2': 0.02 * nrm(ks[19], (DEPTH, N_EXPERTS, D_MODEL), f32),
        'g_final': 1.0 + 0.05 * nrm(ks[20], (D_MODEL,), f32),
    }


def reference(x, c, ctx, c_ctx, w_mod, b_mod, g_norm1, w_in, b_in, g_q, g_k, g_mlstm, w_out,
              g_norm2, w_router, b_router, w1, b1, w2, b2, g_final):
    B, N, D = x.shape[0], x.shape[1], x.shape[2]
    rows = N // GRID_W
    cos, sin = axial_rope_tables(rows)
    for l in range(DEPTH):
        with_ctx = l + 1 < DEPTH
        mod = jax.nn.silu(c) @ w_mod[l] + b_mod[l]
        mod_c = jax.nn.silu(c_ctx) @ w_mod[l] + b_mod[l]
        sh1, sc1, gt1, sh2, sc2, gt2 = jnp.split(mod[:, None, :], N_ADALN, axis=-1)
        sh1c, sc1c, gt1c, sh2c, sc2c, gt2c = jnp.split(mod_c, N_ADALN, axis=-1)
        h_lat = modulate(rmsnorm(x, g_norm1[l]), sh1, sc1)
        h_ctx = modulate(rmsnorm(ctx, g_norm1[l]), sh1c, sc1c)
        y_lat, y_ctx = mixer_group(h_lat, h_ctx, w_in[l], b_in[l], g_q[l], g_k[l], g_mlstm[l], cos, sin, with_ctx)
        x = x + gt1 * (y_lat @ w_out[l])
        h2 = modulate(rmsnorm(x, g_norm2[l]), sh2, sc2)
        x = x + gt2 * moe(h2.reshape(B * N, D), w_router[l], b_router[l], w1[l], b1[l], w2[l], b2[l]).reshape(B, N, D)
        if with_ctx:
            C = ctx.shape[1]
            ctx = ctx + gt1c * (y_ctx @ w_out[l])
            h2c = modulate(rmsnorm(ctx, g_norm2[l]), sh2c, sc2c)
            ctx = ctx + gt2c * moe(h2c.reshape(B * C, D), w_router[l], b_router[l], w1[l], b1[l], w2[l], b2[l]).reshape(B, C, D)
    return rmsnorm(x, g_final)
```

```cpp
#include <hip/hip_runtime.h>
#include <cstdio>
#include <cstdint>

#ifndef MK_ONE_LAUNCH
#define MK_ONE_LAUNCH 1
#endif

#define LAS __attribute__((address_space(3)))
#define GAS __attribute__((address_space(1)))
typedef unsigned short bf16_t;
typedef short bf16x8 __attribute__((ext_vector_type(8)));
typedef short s16x4 __attribute__((ext_vector_type(4)));
typedef float f32x2 __attribute__((ext_vector_type(2)));
typedef float f32x4 __attribute__((ext_vector_type(4)));
typedef float f32x16 __attribute__((ext_vector_type(16)));
typedef unsigned u32x2 __attribute__((ext_vector_type(2)));
typedef unsigned u32x4 __attribute__((ext_vector_type(4)));
typedef GAS unsigned gu32;

constexpr int DM = 2048, NB = 2, SEQ = 4096, CTXL = 256, ROWS_B = SEQ + CTXL  , MROWS = NB * ROWS_B  , NLAT = NB * SEQ  ;
constexpr int GRID_W = 64;
constexpr float EPS = 1e-6f;
constexpr int NH = 8, KVH = 2, HD = 128;
constexpr int MH = 4, MDK = 128, MDV = 256, MCH = 128;
constexpr int IN_COLS = 4624, PW = 4608;
constexpr int C_Q = 0, C_K = 1024, C_V = 1280, C_MQ = 1536, C_MK = 2048, C_MV = 2560, C_MO = 3584, C_G = 4608;
constexpr int NEXP = 32, TOPK = 4, DFF = 2048;
constexpr int NTB = ROWS_B / MCH;
constexpr int NCHAIN = NB * 2 * MH;
constexpr int MAXTILES = 160;

constexpr size_t MiB = 1u << 20;
constexpr size_t WS_CTL = 0, CTL_ZERO_BYTES = 1 * MiB;
constexpr size_t WS_MOD = 1 * MiB;
constexpr size_t WS_WRS = 2 * MiB;
constexpr size_t WS_GATE = 3 * MiB;
constexpr size_t WS_GA = 4 * MiB;
constexpr size_t WS_GM = WS_GA + 512 * 1024;
constexpr size_t WS_GB = WS_GM + 512 * 1024;
constexpr size_t WS_GC = WS_GB + 512 * 1024;
constexpr size_t WS_TOKE = 6 * MiB;
constexpr size_t WS_TOKP = WS_TOKE + 128 * 1024;
constexpr size_t WS_TOKW = WS_TOKP + 128 * 1024;
constexpr size_t WS_LIST = 7 * MiB;
constexpr size_t WS_NL = 8 * MiB;
constexpr size_t WS_NST = 9 * MiB;
constexpr size_t WS_WINT = 16 * MiB;
constexpr size_t WS_WOUTT = 36 * MiB;
constexpr size_t WS_H = 48 * MiB;
constexpr size_t WS_P = 96 * MiB;
constexpr size_t WS_Y = 184 * MiB;
constexpr size_t WS_X1 = 224 * MiB;
constexpr size_t WS_LST = 288 * MiB;
constexpr size_t WS_CST = 368 * MiB;
constexpr size_t WS_ACT = 416 * MiB;
constexpr size_t WS_YB = 576 * MiB;
constexpr size_t WS_W1T = 768 * MiB;
constexpr size_t WS_W2T = 1280 * MiB;
constexpr size_t WS_END = 1536 * MiB;
constexpr int CW_TMO = 0;
constexpr int CW_BAR = 4096;
constexpr int CW_CNT = 8192;
constexpr int CW_FLAG = 16384;
constexpr int CPX = 14;

constexpr int RING_BYTES = 131072;
constexpr int TAB_OFF = 131072;
constexpr int NSLOT = 32;
constexpr int ETAB_OFF = TAB_OFF + 16384;
constexpr int MISC_OFF = ETAB_OFF + 1024;
constexpr int LDS_BYTES = MISC_OFF + 256;

__device__ __forceinline__ unsigned cvt_pk_bf16(float lo, float hi) { unsigned r; asm volatile("v_cvt_pk_bf16_f32 %0, %1, %2" : "=v"(r) : "v"(lo), "v"(hi)); return r; }
__device__ __forceinline__ float bf2f(unsigned short b) { return __uint_as_float(((unsigned)b) << 16); }
__device__ __forceinline__ float bflo(unsigned w) { return __uint_as_float(w << 16); }
__device__ __forceinline__ float bfhi(unsigned w) { return __uint_as_float(w & 0xffff0000u); }
__device__ __forceinline__ float wave_sum(float v) {
#pragma unroll
    for (int o = 1; o < 64; o <<= 1) v += __shfl_xor(v, o);
    return v;
}
#define LDS_WAIT() asm volatile("s_waitcnt lgkmcnt(0)" ::: "memory")
#define VM_WAIT() asm volatile("s_waitcnt vmcnt(0)" ::: "memory")

#define XB_TMO      128
#define XB_XCNT(j)  (256  + 64 * (j))
#define XB_XSUB(j)  (1280 + 64 * (j))
#define XB_XGEN(j)  (2304 + 64 * (j))
#define XB_TOP      3328
#define XB_TOPGEN   3392
#define XCD_BAR_WORDS 3456
#define XB_SPIN_CAP (1u << 22)
__device__ __forceinline__ unsigned xb_ld(unsigned* p)              { return __hip_atomic_load(p, __ATOMIC_RELAXED, __HIP_MEMORY_SCOPE_AGENT); }
__device__ __forceinline__ unsigned xb_add(unsigned* p, unsigned v) { return __hip_atomic_fetch_add(p, v, __ATOMIC_RELAXED, __HIP_MEMORY_SCOPE_AGENT); }
__device__ __forceinline__ unsigned xb_xcc_id() { return (unsigned)__builtin_amdgcn_s_getreg((3 << 11) | 20) & 0xFu; }
#define XB_SPIN(cond, bar) do { unsigned _sp = 0; while (cond) { __builtin_amdgcn_s_sleep(1); \
    if ((++_sp & 255u) == 0u) { if (xb_ld(&(bar)[XB_TMO])) break; if (_sp > XB_SPIN_CAP) { atomicAdd(&(bar)[XB_TMO], 1u); break; } } } } while (0)
struct XcdBarrier { unsigned* bar; unsigned x; volatile LAS unsigned* st; };
__device__ __forceinline__ XcdBarrier xcd_barrier_post(unsigned* bar, volatile LAS unsigned* st) {
    XcdBarrier b; b.bar = bar; b.x = xb_xcc_id(); b.st = st;
    if (threadIdx.x == 0) (void)xb_add(&bar[XB_XCNT(b.x)], 1u);
    return b;
}
__device__ __forceinline__ void xcd_barrier_complete(unsigned* bar, unsigned x, unsigned& nloc, unsigned& nx) {
    const unsigned G = gridDim.x * gridDim.y * gridDim.z;
    unsigned sum, cnt, mine, sp = 0u;
    for (;;) {
        sum = 0u; cnt = 0u; mine = 0u;
#pragma unroll
        for (unsigned j = 0; j < 16; ++j) { const unsigned c = xb_ld(&bar[XB_XCNT(j)]); sum += c; cnt += (c > 0u) ? 1u : 0u; mine = (j == x) ? c : mine; }
        if (sum == G) break;
        __builtin_amdgcn_s_sleep(1);
        if ((++sp & 255u) == 0u) { if (xb_ld(&bar[XB_TMO])) break; if (sp > XB_SPIN_CAP) { atomicAdd(&bar[XB_TMO], 1u); break; } }
    }
    nloc = mine > 0u ? mine : 1u; nx = cnt > 0u ? cnt : 1u;
}
__device__ __forceinline__ void xcd_barrier(const XcdBarrier& b) {
    asm volatile("s_waitcnt vmcnt(0)" ::: "memory");
    __syncthreads();
    if (threadIdx.x == 0) {
        unsigned* bar = b.bar;
        __builtin_amdgcn_s_waitcnt(0);
        unsigned nloc = b.st[0], nx = b.st[1];
        if (nloc == 0u) { xcd_barrier_complete(bar, b.x, nloc, nx); b.st[0] = nloc; b.st[1] = nx; }
        const unsigned old = xb_add(&bar[XB_XSUB(b.x)], 1u);
        const unsigned gen = old / nloc;
        if (old + 1u == (gen + 1u) * nloc) {
            __builtin_amdgcn_fence(__ATOMIC_RELEASE, "agent");
            asm volatile("s_waitcnt vmcnt(0)" ::: "memory");
            const unsigned og = xb_add(&bar[XB_TOP], 1u);
            const unsigned tg = og / nx;
            if (og + 1u == (tg + 1u) * nx) xb_add(&bar[XB_TOPGEN], 1u);
            else XB_SPIN(xb_ld(&bar[XB_TOPGEN]) == tg, bar);
            __builtin_amdgcn_fence(__ATOMIC_ACQUIRE, "agent");
            xb_add(&bar[XB_XGEN(b.x)], 1u);
            asm volatile("s_waitcnt vmcnt(0)" ::: "memory");
        } else {
            XB_SPIN(xb_ld(&bar[XB_XGEN(b.x)]) == gen, bar);
            __builtin_amdgcn_fence(__ATOMIC_ACQUIRE, "agent");
            asm volatile("s_waitcnt vmcnt(0)" ::: "memory");
        }
    }
    __syncthreads();
}

namespace gx {
constexpr int BM = 256, BK = 64, HALF = 128, HTB = HALF * BK * 2, STAGE_BYTES = 8 * HTB, NXCD = 8;
__host__ __device__ __forceinline__ int lds_byte(int r, int c) { const int st = (r >> 4) * 2 + (c >> 5), rr = r & 15, cc = c & 31, ob = rr * 64 + cc * 2; return st * 1024 + (ob ^ (((ob >> 9) & 1) << 5)); }
__host__ __device__ __forceinline__ void stage_rc(int b, int& R, int& C) { const int st = b / 1024, sb = b % 1024, swz = sb ^ (((sb >> 9) & 1) << 5); R = (st >> 1) * 16 + swz / 64; C = (st & 1) * 32 + (swz % 64) / 2; }
__host__ __device__ __forceinline__ int perm32(int rho) { const int n = rho >> 4, i = rho & 15; return 8 * (i >> 2) + 4 * n + (i & 3); }

struct Unit { const char* A; const char* B0; const char* B1; int slot, pm, pn, e; };

typedef int i32x8 __attribute__((ext_vector_type(8)));
__device__ __forceinline__ i32x8 cat8(bf16x8 lo, bf16x8 hi) { typedef int i32x4 __attribute__((ext_vector_type(4))); const i32x4 a = __builtin_bit_cast(i32x4, lo), b = __builtin_bit_cast(i32x4, hi); return (i32x8){a.x, a.y, a.z, a.w, b.x, b.y, b.z, b.w}; }
template <class Epi, class Sched, bool FP8 = false>
__device__ __forceinline__ void gemm_run(LAS unsigned char* lds, const Sched& S, const Epi& E, const int nt, const int ldb, const unsigned apitch  ) {
    const int tid = threadIdx.x, wid = __builtin_amdgcn_readfirstlane(tid >> 6), lane = tid & 63, wr = wid >> 2, wc = wid & 3, fr = lane & 15, fq = lane >> 4;
    unsigned voffB[2], colA[2]; int rowA[2];
#pragma unroll
    for (int i = 0; i < 2; ++i) { int R, C; stage_rc(tid * 16 + i * 8192, R, C); const int Rb = Epi::PERM ? ((R & ~31) + perm32(R & 31)) : R;
        voffB[i] = (unsigned)(Rb * ldb + C) * 2u; rowA[i] = R; colA[i] = (unsigned)C * 2u; }
    const LAS unsigned short* tab = (const LAS unsigned short*)(lds + TAB_OFF);
    unsigned vA0[2], vA1[2];
#define GX_LOADTAB(slot) do { _Pragma("unroll") for (int _i = 0; _i < 2; ++_i) { vA0[_i] = (unsigned)tab[(slot) * 256 + rowA[_i]] * apitch + colA[_i]; vA1[_i] = (unsigned)tab[(slot) * 256 + 128 + rowA[_i]] * apitch + colA[_i]; } } while (0)
    const size_t kstep = (size_t)(BK * 2);
    const unsigned ldsw = (unsigned)wid * 1024u;
    const int aoff = lds_byte(wr * 64 + fr, fq * 8), boff = lds_byte(wc * 32 + fr, fq * 8);
#define GX_SA(b, h) (((b) * 2 + (h)) * HTB)
#define GX_SB(b, h) ((4 + (b) * 2 + (h)) * HTB)
#define GX_STAGE(bufoff, gbase, voff) do { _Pragma("unroll") for (int _i = 0; _i < 2; ++_i) \
        __builtin_amdgcn_global_load_lds((const unsigned*)((const char*)(gbase) + (voff)[_i]), (LAS unsigned*)(lds + (bufoff) + ldsw + _i * 8192), 16, 0, 0); } while (0)
#define GX_LDA(dst, b, h) do { _Pragma("unroll") for (int m = 0; m < 4; ++m) _Pragma("unroll") for (int k = 0; k < 2; ++k) dst[m][k] = *(const LAS bf16x8*)(lds + GX_SA(b, h) + aoff + m * 2048 + k * 1024); } while (0)
#define GX_LDB(dst, b, h) do { _Pragma("unroll") for (int n = 0; n < 2; ++n) _Pragma("unroll") for (int k = 0; k < 2; ++k) dst[n][k] = *(const LAS bf16x8*)(lds + GX_SB(b, h) + boff + n * 2048 + k * 1024); } while (0)
#define GX_MMA(ai, bj, At, Bt) do { __builtin_amdgcn_s_setprio(1); _Pragma("unroll") for (int m = 0; m < 4; ++m) _Pragma("unroll") for (int n = 0; n < 2; ++n) { \
        if constexpr (FP8) acc[ai][bj][m][n] = __builtin_amdgcn_mfma_scale_f32_16x16x128_f8f6f4(cat8(Bt[n][0], Bt[n][1]), cat8(At[m][0], At[m][1]), acc[ai][bj][m][n], 0, 0, 0, 0x7f7f7f7f, 0, 0x7f7f7f7f); \
        else { _Pragma("unroll") for (int k = 0; k < 2; ++k) acc[ai][bj][m][n] = __builtin_amdgcn_mfma_f32_16x16x32_bf16(Bt[n][k], At[m][k], acc[ai][bj][m][n], 0, 0, 0); } } \
        __builtin_amdgcn_s_setprio(0); } while (0)
#define GX_WAIT_V(n) asm volatile("s_waitcnt vmcnt(" #n ")" ::: "memory")
#define GX_WAIT_L(n) asm volatile("s_waitcnt lgkmcnt(" #n ")" ::: "memory")
#define GX_BAR __builtin_amdgcn_s_barrier()
#define GX_SCHED __builtin_amdgcn_sched_barrier(0)
    Unit cur, nxt; int ui = 0;
    if (!S.next(0, cur)) return;
    f32x4 acc[2][2][4][2];
#pragma unroll
    for (int a = 0; a < 2; ++a)
#pragma unroll
        for (int b = 0; b < 2; ++b)
#pragma unroll
            for (int m = 0; m < 4; ++m)
#pragma unroll
                for (int n = 0; n < 2; ++n) acc[a][b][m][n] = (f32x4){0.f, 0.f, 0.f, 0.f};
    bf16x8 At[4][2], B0[2][2], B1[2][2];
    const char* cA = cur.A; const char* cB0 = cur.B0; const char* cB1 = cur.B1;
    S.a_ready(cur);
    GX_LOADTAB(cur.slot);
    GX_STAGE(GX_SB(0, 0), cB0, voffB); GX_STAGE(GX_SB(0, 1), cB1, voffB); GX_STAGE(GX_SA(0, 0), cA, vA0); GX_STAGE(GX_SA(0, 1), cA, vA1);
    if (wr == 1) GX_BAR;
    GX_WAIT_V(2); GX_BAR;
    GX_STAGE(GX_SB(1, 0), cB0 + kstep, voffB); GX_STAGE(GX_SA(1, 0), cA + kstep, vA0); GX_STAGE(GX_SB(1, 1), cB1 + kstep, voffB);
    GX_WAIT_V(6); GX_BAR;
    for (;;) {
        const bool has_next = S.next(ui + 1, nxt);
        const char* nA = has_next ? nxt.A : cA; const char* nB0 = has_next ? nxt.B0 : cB0; const char* nB1 = has_next ? nxt.B1 : cB1;
        for (int t = 0; t < nt; t += 2) {
            const bool last = (t == nt - 2);
            const char* a1 = cA + (size_t)(t + 1) * kstep;
            const char* a2 = last ? nA : cA + (size_t)(t + 2) * kstep;
            const char* b20 = last ? nB0 : cB0 + (size_t)(t + 2) * kstep; const char* b21 = last ? nB1 : cB1 + (size_t)(t + 2) * kstep;
            const char* a3 = a2 + kstep; const char* b30 = b20 + kstep; const char* b31 = b21 + kstep;
            if (last && has_next) S.a_ready(nxt);
            GX_LDB(B0, 0, 0); GX_LDB(B1, 0, 1); GX_SCHED; GX_LDA(At, 0, 0); GX_STAGE(GX_SA(1, 1), a1, vA1);
            if (last && has_next) GX_LOADTAB(nxt.slot);
            GX_WAIT_V(8); GX_WAIT_L(0); GX_BAR; GX_MMA(0, 0, At, B0); GX_MMA(0, 1, At, B1); GX_BAR; GX_SCHED;
            GX_LDA(At, 0, 1); GX_STAGE(GX_SB(0, 0), b20, voffB); GX_STAGE(GX_SB(0, 1), b21, voffB); GX_STAGE(GX_SA(0, 0), a2, vA0);
            GX_WAIT_V(8); GX_WAIT_L(0); GX_BAR; GX_MMA(1, 0, At, B0); GX_MMA(1, 1, At, B1); GX_BAR; GX_SCHED;
            GX_LDB(B0, 1, 0); GX_LDB(B1, 1, 1); GX_SCHED; GX_LDA(At, 1, 0); GX_STAGE(GX_SA(0, 1), a2, vA1);
            GX_WAIT_V(8); GX_WAIT_L(0); GX_BAR; GX_MMA(0, 0, At, B0); GX_MMA(0, 1, At, B1); GX_BAR; GX_SCHED;
            GX_LDA(At, 1, 1); GX_STAGE(GX_SB(1, 0), b30, voffB); GX_STAGE(GX_SB(1, 1), b31, voffB); GX_STAGE(GX_SA(1, 0), a3, vA0);
            GX_WAIT_V(8); GX_WAIT_L(0); GX_BAR; GX_MMA(1, 0, At, B0); GX_MMA(1, 1, At, B1); GX_BAR; GX_SCHED;
        }
        if (wr == 0) GX_BAR;
        E(acc, cur, wr, wc, fr, fq);
        if (!has_next) break;
#pragma unroll
        for (int a = 0; a < 2; ++a)
#pragma unroll
            for (int b = 0; b < 2; ++b)
#pragma unroll
                for (int m = 0; m < 4; ++m)
#pragma unroll
                    for (int n = 0; n < 2; ++n) acc[a][b][m][n] = (f32x4){0.f, 0.f, 0.f, 0.f};
        cur = nxt; cA = nA; cB0 = nB0; cB1 = nB1; ++ui;
        if (wr == 1) GX_BAR;
    }
    GX_WAIT_V(0);
    GX_BAR;
#undef GX_LOADTAB
#undef GX_SA
#undef GX_SB
#undef GX_STAGE
#undef GX_LDA
#undef GX_LDB
#undef GX_MMA
#undef GX_WAIT_V
#undef GX_WAIT_L
#undef GX_BAR
#undef GX_SCHED
}

struct EpiBf16Bias {
    static constexpr bool PERM = true;
    bf16_t* O; int ldc; const float* bias; int bias_estride; float ascale;
    __device__ __forceinline__ void operator()(const f32x4 (&acc)[2][2][4][2], const Unit& u, int wr, int wc, int fr, int fq) const {
        const int row0 = u.pm * BM + wr * 64 + fr, col0 = u.pn * BM + wc * 32 + 8 * fq;
        const float* bp = bias + (size_t)u.e * bias_estride + col0;
        f32x4 bv[2][2];
#pragma unroll
        for (int bj = 0; bj < 2; ++bj)
#pragma unroll
            for (int n = 0; n < 2; ++n) bv[bj][n] = *(const f32x4*)(bp + bj * HALF + 4 * n);
#pragma unroll
        for (int ai = 0; ai < 2; ++ai)
#pragma unroll
            for (int m = 0; m < 4; ++m) { bf16_t* rowp = O + (size_t)(row0 + ai * HALF + m * 16) * ldc + col0;
#pragma unroll
                for (int bj = 0; bj < 2; ++bj) { const f32x4 v0 = acc[ai][bj][m][0] * ascale + bv[bj][0], v1 = acc[ai][bj][m][1] * ascale + bv[bj][1];
                    u32x4 w; w.x = cvt_pk_bf16(v0[0], v0[1]); w.y = cvt_pk_bf16(v0[2], v0[3]); w.z = cvt_pk_bf16(v1[0], v1[1]); w.w = cvt_pk_bf16(v1[2], v1[3]);
                    *(u32x4*)(rowp + bj * HALF) = w; } }
    }
};
struct EpiInProj {
    static constexpr bool PERM = true;
    bf16_t* O; float* gate; const float* bias;
    __device__ __forceinline__ void operator()(const f32x4 (&acc)[2][2][4][2], const Unit& u, int wr, int wc, int fr, int fq) const {
        if (u.pn < 18) { EpiBf16Bias E{O, PW, bias, 0, 1.0f}; E(acc, u, wr, wc, fr, fq); return; }
        if (wc == 0 && fq < 2) { const int row0 = u.pm * BM + wr * 64 + fr; const float* bp = bias + C_G + 8 * fq;
            const f32x4 b0 = *(const f32x4*)bp, b1 = *(const f32x4*)(bp + 4);
#pragma unroll
            for (int ai = 0; ai < 2; ++ai)
#pragma unroll
                for (int m = 0; m < 4; ++m) { float* gp = gate + (size_t)(row0 + ai * HALF + m * 16) * 16 + 8 * fq;
                    *(f32x4*)gp = acc[ai][0][m][0] + b0; *(f32x4*)(gp + 4) = acc[ai][0][m][1] + b1; } }
    }
};
struct EpiOutProj {
    static constexpr bool PERM = false;
    const float* x; float* x1; const float* mod;
    __device__ __forceinline__ void operator()(const f32x4 (&acc)[2][2][4][2], const Unit& u, int wr, int wc, int fr, int fq) const {
        const int row0 = u.pm * BM + wr * 64 + fr, col0 = u.pn * BM + wc * 32 + 4 * fq;
        const int b = u.pm >> 4;
        const float* gp = mod + (size_t)b * 12288 + 4096 + col0;
        f32x4 gv[2][2];
#pragma unroll
        for (int bj = 0; bj < 2; ++bj)
#pragma unroll
            for (int n = 0; n < 2; ++n) gv[bj][n] = *(const f32x4*)(gp + bj * HALF + n * 16);
#pragma unroll
        for (int ai = 0; ai < 2; ++ai)
#pragma unroll
            for (int m = 0; m < 4; ++m) { const size_t off = (size_t)(row0 + ai * HALF + m * 16) * DM + col0;
#pragma unroll
                for (int bj = 0; bj < 2; ++bj)
#pragma unroll
                    for (int n = 0; n < 2; ++n) { const f32x4 xv = *(const f32x4*)(x + off + bj * HALF + n * 16);
                        *(f32x4*)(x1 + off + bj * HALF + n * 16) = xv + gv[bj][n] * acc[ai][bj][m][n]; } }
    }
};
struct EpiMoe1 {
    static constexpr bool PERM = true;
    unsigned char* act; const float* b1; float ascale;
    __device__ __forceinline__ void operator()(const f32x4 (&acc)[2][2][4][2], const Unit& u, int wr, int wc, int fr, int fq) const {
        const int row0 = u.pm * BM + wr * 64 + fr, c0 = u.pn * HALF + wc * 32 + 8 * fq;
        const float* bp = b1 + (size_t)u.e * 4096 + c0;
        f32x4 bg[2], bu[2];
#pragma unroll
        for (int n = 0; n < 2; ++n) { bg[n] = *(const f32x4*)(bp + 4 * n); bu[n] = *(const f32x4*)(bp + 2048 + 4 * n); }
#pragma unroll
        for (int ai = 0; ai < 2; ++ai)
#pragma unroll
            for (int m = 0; m < 4; ++m) { unsigned char* rowp = act + (size_t)(row0 + ai * HALF + m * 16) * DFF + c0;
                float o[8];
#pragma unroll
                for (int n = 0; n < 2; ++n)
#pragma unroll
                    for (int j = 0; j < 4; ++j) { float g = acc[ai][0][m][n][j] * ascale + bg[n][j], up = acc[ai][1][m][n][j] * ascale + bu[n][j];
                        g = fminf(g, 7.0f); up = fminf(fmaxf(up, -7.0f), 7.0f);
                        const float glu = g * __builtin_amdgcn_rcpf(1.0f + __expf(-1.702f * g));
                        o[n * 4 + j] = (up + 1.0f) * glu; }
                int w0 = 0, w1 = 0;
                w0 = __builtin_amdgcn_cvt_pk_fp8_f32(o[0], o[1], w0, false); w0 = __builtin_amdgcn_cvt_pk_fp8_f32(o[2], o[3], w0, true);
                w1 = __builtin_amdgcn_cvt_pk_fp8_f32(o[4], o[5], w1, false); w1 = __builtin_amdgcn_cvt_pk_fp8_f32(o[6], o[7], w1, true);
                *(u32x2*)rowp = (u32x2){(unsigned)w0, (unsigned)w1}; }
    }
};

struct PlainSched {
    const char* A; const char* Bt; int K; int nM, nN, nwg, G, c;
    __device__ __forceinline__ void init(const void* A_, const void* Bt_, int M, int N, int K_, int G_, int c_) { A = (const char*)A_; Bt = (const char*)Bt_; K = K_; nM = M / BM; nN = N / BM; nwg = nM * nN; G = G_; c = c_; }
    __device__ __forceinline__ bool tile(int i, int& pm, int& pn) const {
        const long L = (long)i * G + c; if (L >= nwg || i >= NSLOT) return false;
        int wgid = (int)L; { const int q = nwg / NXCD, r = nwg % NXCD, xcd = wgid % NXCD, off = wgid / NXCD; wgid = (xcd < r ? xcd * (q + 1) : r * (q + 1) + (xcd - r) * q) + off; }
        const int WGM = 8, nig = WGM * nN, gid = wgid / nig, fm = gid * WGM, gsz = (nM - fm) < WGM ? (nM - fm) : WGM;
        pm = fm + ((wgid % nig) % gsz); pn = (wgid % nig) / gsz; return true;
    }
    __device__ __forceinline__ bool next(int i, Unit& u) const {
        int pm, pn; if (!tile(i, pm, pn)) return false;
        u.A = A; u.B0 = Bt + (size_t)pn * BM * K * 2; u.B1 = u.B0 + (size_t)HALF * K * 2; u.slot = i; u.pm = pm; u.pn = pn; u.e = 0; return true;
    }
    __device__ __forceinline__ void a_ready(const Unit&) const {}
    __device__ __forceinline__ void build_tables(LAS unsigned char* lds) const {
        LAS unsigned short* tab = (LAS unsigned short*)(lds + TAB_OFF);
        for (int i = 0; i < NSLOT; ++i) { int pm, pn; if (!tile(i, pm, pn)) break;
            if (threadIdx.x < 256) tab[i * 256 + threadIdx.x] = (unsigned short)(pm * BM + threadIdx.x); }
    }
};
template <int NT  , bool GATHER>
struct MoeSched {
    const char* A; const char* W; LAS const int* et; int nunits, G, c; const int* list; unsigned* flags; unsigned* tmo;
    __device__ __forceinline__ void init(const void* A_, const void* W_, LAS unsigned char* lds, int G_, int c_, const int* list_, unsigned* flags_ = nullptr, unsigned* tmo_ = nullptr) {
        A = (const char*)A_; W = (const char*)W_; et = (LAS const int*)(lds + ETAB_OFF); G = G_; c = c_; list = list_; flags = flags_; tmo = tmo_;
        nunits = __builtin_amdgcn_readfirstlane(et[64 + 32]) * NT;
    }
    __device__ __forceinline__ bool map(int i, int& e, int& nt, int& mt) const {
        const long L = (long)i * G + c; if (L >= nunits || i >= NSLOT) return false;
        int wgid = (int)L; { const int q = nunits / NXCD, r = nunits % NXCD, xcd = wgid % NXCD, off = wgid / NXCD; wgid = (xcd < r ? xcd * (q + 1) : r * (q + 1) + (xcd - r) * q) + off; }
        const int lane = threadIdx.x & 63, le = lane & 31;
        const int t0 = et[64 + le] * NT, t1 = et[64 + le + 1] * NT;
        const unsigned long long hit = __ballot(wgid >= t0 && wgid < t1);
        e = __builtin_amdgcn_readfirstlane((int)__builtin_ctzll(hit)) & 31;
        const int ub = __builtin_amdgcn_readfirstlane(et[64 + e]) * NT, tl = __builtin_amdgcn_readfirstlane(et[32 + e]);
        const int local = wgid - ub; nt = local / tl; mt = local - nt * tl; return true;
    }
    __device__ __forceinline__ bool next(int i, Unit& u) const {
        int e, nt, mt; if (!map(i, e, nt, mt)) return false;
        const int tb = __builtin_amdgcn_readfirstlane(et[64 + e]);
        u.A = A; u.slot = i; u.pm = tb + mt; u.pn = nt; u.e = e;
        if (NT == 16) { u.B0 = W + ((size_t)e * 4096 + (size_t)nt * HALF) * DM; u.B1 = u.B0 + (size_t)2048 * DM; }
        else { u.B0 = W + ((size_t)e * 2048 + (size_t)nt * BM) * DFF; u.B1 = u.B0 + (size_t)HALF * DFF; }
        return true;
    }
    __device__ __forceinline__ void a_ready(const Unit& u) const {
        if (flags == nullptr) return;
        if (threadIdx.x < 64) {
            unsigned* w = flags + 64 * (u.e * 16 + u.pn); unsigned spins = 0;
            while ((unsigned)__builtin_amdgcn_readfirstlane(__hip_atomic_load(w, __ATOMIC_RELAXED, __HIP_MEMORY_SCOPE_AGENT)) < 128u) {
                __builtin_amdgcn_s_sleep(2);
                if ((++spins & 255u) == 0u) { if (__builtin_amdgcn_readfirstlane(__hip_atomic_load(tmo, __ATOMIC_RELAXED, __HIP_MEMORY_SCOPE_AGENT)) != 0u) break;
                    if (spins > (1u << 20)) { if (threadIdx.x == 0) __hip_atomic_store(tmo, 1u, __ATOMIC_RELAXED, __HIP_MEMORY_SCOPE_AGENT); break; } } }
            __builtin_amdgcn_fence(__ATOMIC_ACQUIRE, "agent");
            asm volatile("s_waitcnt vmcnt(0)" ::: "memory");
        }
        asm volatile("" ::: "memory"); __builtin_amdgcn_s_barrier(); asm volatile("" ::: "memory");
    }
    __device__ __forceinline__ void build_tables(LAS unsigned char* lds) const {
        LAS unsigned short* tab = (LAS unsigned short*)(lds + TAB_OFF);
        for (int i = 0; i < NSLOT; ++i) { int e, nt, mt; if (!map(i, e, nt, mt)) break;
            if (threadIdx.x < 256) { int row;
                if (GATHER) { const int pos = mt * BM + (int)threadIdx.x; const int cnt = et[e]; row = pos < cnt ? list[e * 8192 + pos] : 0; }
                else row = (et[64 + e] + mt) * BM + (int)threadIdx.x;
                tab[i * 256 + threadIdx.x] = (unsigned short)row; } }
    }
};
}

namespace att {
constexpr int D = 128, NW = 8, QBLK = 32, KVBLK = 64;
constexpr float SCALE = 0.088388347648318440f;
constexpr float THR = 8.f;
constexpr int SHM_V = KVBLK * D * 2, SHM_K = KVBLK * D * 2, SHM_ATTN = 2 * SHM_V + 2 * SHM_K + NW * 64 * 4;
#define KSWZ(row, colB) ((row) * 256 + ((colB) ^ (((row) & 7) << 4)))
#define SBAR() __builtin_amdgcn_sched_barrier(0)
__device__ __forceinline__ int crow(int r, int hi) { return (r & 3) + 8 * (r >> 2) + 4 * hi; }
__device__ __forceinline__ void partialSM(f32x16& p0, f32x16& p1, float& m_reg, float& mn, float& alpha) {
  constexpr float C = SCALE * 1.4426950408889634f;
  float pmax = p0[0];
#pragma unroll
  for (int r = 1; r < 16; ++r) pmax = fmaxf(pmax, p0[r]);
#pragma unroll
  for (int r = 0; r < 16; ++r) pmax = fmaxf(pmax, p1[r]);
  { auto rr = __builtin_amdgcn_permlane32_swap(__float_as_uint(pmax), __float_as_uint(pmax), false, false);
    pmax = fmaxf(__uint_as_float(rr[0]), __uint_as_float(rr[1])); }
  if (__builtin_expect(__all(pmax - m_reg <= THR / SCALE), 1)) { mn = m_reg; alpha = 1.f; }
  else { mn = fmaxf(m_reg, pmax); alpha = __builtin_amdgcn_exp2f((m_reg - mn) * C); m_reg = mn; }
  float mnC = -mn * C;
#pragma unroll
  for (int r = 0; r < 16; ++r) p0[r] = fmaf(p0[r], C, mnC);
#pragma unroll
  for (int r = 0; r < 16; ++r) p1[r] = fmaf(p1[r], C, mnC);
#pragma unroll
  for (int r = 0; r < 16; ++r) p0[r] = __builtin_amdgcn_exp2f(p0[r]);
}
#define PK4(P, BASE, OUT) do { unsigned a0 = cvt_pk_bf16(P[BASE + 0], P[BASE + 1]), a1 = cvt_pk_bf16(P[BASE + 2], P[BASE + 3]);   \
    unsigned b0 = cvt_pk_bf16(P[BASE + 4], P[BASE + 5]), b1 = cvt_pk_bf16(P[BASE + 6], P[BASE + 7]);                              \
    auto r0 = __builtin_amdgcn_permlane32_swap(a0, b0, false, false); auto r1 = __builtin_amdgcn_permlane32_swap(a1, b1, false, false); \
    u32x4 w = {r0[0], r1[0], r0[1], r1[1]}; OUT = *reinterpret_cast<bf16x8*>(&w); } while (0)
__device__ __forceinline__ void finishSM(f32x16& p0, f32x16& p1, float alpha, float& l_reg, bf16x8& pa0, bf16x8& pa1, bf16x8& pa2, bf16x8& pa3) {
#pragma unroll
  for (int r = 0; r < 16; ++r) p1[r] = __builtin_amdgcn_exp2f(p1[r]);
  float ps = 0;
#pragma unroll
  for (int r = 0; r < 16; ++r) ps += p0[r];
#pragma unroll
  for (int r = 0; r < 16; ++r) ps += p1[r];
  { auto rr = __builtin_amdgcn_permlane32_swap(__float_as_uint(ps), __float_as_uint(ps), false, false);
    ps = __uint_as_float(rr[0]) + __uint_as_float(rr[1]); }
  l_reg = l_reg * alpha + ps;
  PK4(p0, 0, pa0); PK4(p0, 8, pa1); PK4(p1, 0, pa2); PK4(p1, 8, pa3);
}
__device__ __forceinline__ void qkt(f32x16& p0, f32x16& p1, const char* Ks, const bf16x8* qr, int r32, int hi) {
  p0 = f32x16{}; p1 = f32x16{};
#pragma unroll
  for (int d0 = 0; d0 < 8; ++d0) { int cb = (d0 * 16 + hi * 8) * 2;
    bf16x8 b0 = *reinterpret_cast<const bf16x8*>(Ks + KSWZ(r32, cb));
    bf16x8 b1 = *reinterpret_cast<const bf16x8*>(Ks + KSWZ(32 + r32, cb));
    p0 = __builtin_amdgcn_mfma_f32_32x32x16_bf16(b0, qr[d0], p0, 0, 0, 0);
    p1 = __builtin_amdgcn_mfma_f32_32x32x16_bf16(b1, qr[d0], p1, 0, 0, 0); }
}
__device__ __forceinline__ int v_st(int k, int c) { const int kk = (k & ~0xC) | ((k & 4) << 1) | ((k & 8) >> 1); return ((kk >> 3) * 4 + (c >> 5)) * 512 + ((kk & 7) * 32 + (c & 31)) * 2; }
__device__ __forceinline__ int v_rd_base(int lane) { return ((lane & 3) << 3) | (((lane >> 2) & 3) << 6) | (((lane >> 4) & 1) << 5) | (((lane >> 5) & 1) << 8); }
constexpr int v_rd_off(int d0, int ks, int half) { return d0 * 512 + ks * 4096 + half * 2048; }
template <int OFF> __device__ __forceinline__ s16x4 tr_read(int vb) {
  s16x4 r; asm volatile("ds_read_b64_tr_b16 %0, %1 offset:%2" : "=&v"(r) : "v"(vb), "i"(OFF) : "memory"); return r;
}
#define PKLH(L, H) (bf16x8){L[0], L[1], L[2], L[3], H[0], H[1], H[2], H[3]}
template <int D0> __device__ __forceinline__ void pv_one(f32x16& od, int vb, bf16x8 pa0, bf16x8 pa1, bf16x8 pa2, bf16x8 pa3) {
  const s16x4 l0 = tr_read<v_rd_off(D0, 0, 0)>(vb), h0 = tr_read<v_rd_off(D0, 0, 1)>(vb), l1 = tr_read<v_rd_off(D0, 1, 0)>(vb), h1 = tr_read<v_rd_off(D0, 1, 1)>(vb);
  const s16x4 l2 = tr_read<v_rd_off(D0, 2, 0)>(vb), h2 = tr_read<v_rd_off(D0, 2, 1)>(vb), l3 = tr_read<v_rd_off(D0, 3, 0)>(vb), h3 = tr_read<v_rd_off(D0, 3, 1)>(vb);
  asm volatile("s_waitcnt lgkmcnt(0)" ::: "memory"); SBAR();
  od = __builtin_amdgcn_mfma_f32_32x32x16_bf16(pa0, PKLH(l0, h0), od, 0, 0, 0);
  od = __builtin_amdgcn_mfma_f32_32x32x16_bf16(pa1, PKLH(l1, h1), od, 0, 0, 0);
  od = __builtin_amdgcn_mfma_f32_32x32x16_bf16(pa2, PKLH(l2, h2), od, 0, 0, 0);
  od = __builtin_amdgcn_mfma_f32_32x32x16_bf16(pa3, PKLH(l3, h3), od, 0, 0, 0);
}
__device__ __forceinline__ void pv_d0(f32x16* o, int vb, bf16x8 pa0, bf16x8 pa1, bf16x8 pa2, bf16x8 pa3) {
  pv_one<0>(o[0], vb, pa0, pa1, pa2, pa3); pv_one<1>(o[1], vb, pa0, pa1, pa2, pa3); pv_one<2>(o[2], vb, pa0, pa1, pa2, pa3); pv_one<3>(o[3], vb, pa0, pa1, pa2, pa3);
}
template <int LDQ, int LDK, int LDO>
__device__ __forceinline__ void attn_dense_body(const bf16_t* __restrict__ Qb, const bf16_t* __restrict__ Kh, const bf16_t* __restrict__ Vh,
                                                bf16_t* __restrict__ Ob, int seq, char* lds) {
  const int tid = threadIdx.x, wid = tid >> 6, lane = tid & 63, r32 = lane & 31, hi = lane >> 5;
  char* V_lds = lds; char* K_lds = lds + 2 * SHM_V;
  float* ws = (float*)(lds + 2 * SHM_V + 2 * SHM_K) + wid * 64; float* li_l = ws; float* al_l = ws + 32;
  float m_reg = -1e30f, l_reg = 0; f32x16 o[4] = {}; bf16x8 qr[8];
  const bf16_t* Qw = Qb + (long)(wid * QBLK + r32) * LDQ + hi * 8;
#pragma unroll
  for (int d0 = 0; d0 < 8; ++d0) qr[d0] = *reinterpret_cast<const bf16x8*>(Qw + d0 * 16);
  const int sr = tid >> 4, sc = (tid & 15) * 8, vst0 = v_st(sr, sc), vst1 = v_st(32 + sr, sc);
  const int vb0 = (int)(uintptr_t)V_lds + v_rd_base(lane);
  struct { bf16x8 vs0, vs1, ks0, ks1; } sr_[2];
#define SLOAD(i, k0) do { sr_[i].vs0 = *reinterpret_cast<const bf16x8*>(&Vh[(long)((k0) + sr) * LDK + sc]); sr_[i].vs1 = *reinterpret_cast<const bf16x8*>(&Vh[(long)((k0) + 32 + sr) * LDK + sc]); \
    sr_[i].ks0 = *reinterpret_cast<const bf16x8*>(&Kh[(long)((k0) + sr) * LDK + sc]); sr_[i].ks1 = *reinterpret_cast<const bf16x8*>(&Kh[(long)((k0) + 32 + sr) * LDK + sc]); } while (0)
#define SWRITE(b, i) do { *(bf16x8*)(V_lds + (b) * SHM_V + vst0) = sr_[i].vs0;          \
    *(bf16x8*)(V_lds + (b) * SHM_V + vst1) = sr_[i].vs1; int kc = sc * 2;               \
    *(bf16x8*)(K_lds + (b) * SHM_K + KSWZ(sr, kc)) = sr_[i].ks0;                       \
    *(bf16x8*)(K_lds + (b) * SHM_K + KSWZ(32 + sr, kc)) = sr_[i].ks1; } while (0)
#define SWAIT() asm volatile("s_waitcnt vmcnt(4)" ::: "memory")
#define RESC(a) do { if (__any((a) < 1.f)) { if (hi == 0) al_l[r32] = (a); asm volatile("s_waitcnt lgkmcnt(0)" ::: "memory"); \
    _Pragma("unroll") for (int d = 0; d < 4; ++d) _Pragma("unroll") for (int r = 0; r < 16; ++r) o[d][r] *= al_l[crow(r, hi)]; } } while (0)
  f32x16 pA0, pA1, pB0, pB1; float mnA, mnB, alA, alB; bf16x8 pa0, pa1, pa2, pa3; const int NT = seq / KVBLK;
  constexpr int SE = 0, SO = 1;
  SLOAD(SE, 0); asm volatile("s_waitcnt vmcnt(0)" ::: "memory"); SWRITE(0, SE); __syncthreads();
  qkt(pA0, pA1, K_lds, qr, r32, hi); partialSM(pA0, pA1, m_reg, mnA, alA);
  SLOAD(SO, KVBLK); if (2 < NT) SLOAD(SE, 2 * KVBLK);
  SWAIT(); SWRITE(1, SO); __syncthreads();
  for (int j = 1; j + 1 < NT; j += 2) {
    SBAR(); qkt(pB0, pB1, K_lds + SHM_K, qr, r32, hi);
    finishSM(pA0, pA1, alA, l_reg, pa0, pa1, pa2, pa3); SBAR();
    SLOAD(SO, (j + 2) * KVBLK); SBAR();
    pv_d0(o, vb0, pa0, pa1, pa2, pa3); partialSM(pB0, pB1, m_reg, mnB, alB);
    __syncthreads(); SWAIT(); SWRITE(0, SE);
    RESC(alB); __syncthreads();
    SBAR(); qkt(pA0, pA1, K_lds, qr, r32, hi);
    finishSM(pB0, pB1, alB, l_reg, pa0, pa1, pa2, pa3); SBAR();
    if (j + 3 < NT) SLOAD(SE, (j + 3) * KVBLK); SBAR();
    pv_d0(o, vb0 + (int)SHM_V, pa0, pa1, pa2, pa3); partialSM(pA0, pA1, m_reg, mnA, alA);
    __syncthreads(); SWAIT(); SWRITE(1, SO);
    RESC(alA); __syncthreads();
  }
  SBAR(); qkt(pB0, pB1, K_lds + SHM_K, qr, r32, hi);
  finishSM(pA0, pA1, alA, l_reg, pa0, pa1, pa2, pa3); SBAR();
  pv_d0(o, vb0, pa0, pa1, pa2, pa3); partialSM(pB0, pB1, m_reg, mnB, alB);
  __syncthreads(); RESC(alB);
  finishSM(pB0, pB1, alB, l_reg, pa0, pa1, pa2, pa3); SBAR();
  pv_d0(o, vb0 + (int)SHM_V, pa0, pa1, pa2, pa3);
  if (hi == 0) li_l[r32] = l_reg; asm volatile("s_waitcnt lgkmcnt(0)" ::: "memory");
  float rli[16];
#pragma unroll
  for (int r = 0; r < 16; ++r) rli[r] = __builtin_amdgcn_rcpf(li_l[crow(r, hi)]);
  bf16_t* Ow = Ob + (long)(wid * QBLK) * LDO;
#pragma unroll
  for (int r = 0; r < 16; ++r) { int orow = crow(r, hi);
#pragma unroll
    for (int d0 = 0; d0 < 4; ++d0) { const float v = o[d0][r] * rli[r]; Ow[(long)orow * LDO + d0 * 32 + r32] = (bf16_t)(cvt_pk_bf16(v, v) & 0xffffu); } }
  __syncthreads();
#undef SLOAD
#undef SWRITE
#undef SWAIT
#undef RESC
}
}

struct Args { const float* in[21]; float* out; unsigned char* ws; int ph_lo, ph_hi; };
enum { I_X = 0, I_C, I_CTX, I_CCTX, I_WMOD, I_BMOD, I_GN1, I_WIN, I_BIN, I_GQ, I_GK, I_GML, I_WOUT, I_GN2, I_WR, I_BR, I_W1, I_B1, I_W2, I_B2, I_GF };
struct Frame { LAS unsigned char* lds; char* ldsg; int tid, lane, wave, vcu, G; unsigned char* ws; };
constexpr int NWAVES = 8, NTHR = 512;

__device__ __forceinline__ void cvt_item(const float* __restrict__ W, int ldw, bf16_t* __restrict__ WT, int item, int nblk, int lane) {
    const int kb = item / nblk, nb = item - kb * nblk, k0 = 64 * kb, n0 = 32 * nb, kg = lane >> 3, ng = lane & 7;
    const float* src = W + (size_t)(k0 + 8 * kg) * ldw + n0 + 4 * ng;
    f32x4 v[8];
#pragma unroll
    for (int i = 0; i < 8; ++i) v[i] = __builtin_nontemporal_load((const f32x4*)(src + (size_t)i * ldw));
    bf16_t* dst = WT + (size_t)(n0 + 4 * ng) * 2048 + k0 + 8 * kg;
#pragma unroll
    for (int j = 0; j < 4; ++j) { u32x4 w; w.x = cvt_pk_bf16(v[0][j], v[1][j]); w.y = cvt_pk_bf16(v[2][j], v[3][j]); w.z = cvt_pk_bf16(v[4][j], v[5][j]); w.w = cvt_pk_bf16(v[6][j], v[7][j]);
        __builtin_nontemporal_store(w, (u32x4*)(dst + (size_t)j * 2048)); }
}
template <bool WT_SC1>
__device__ __forceinline__ void cvt_item8(const float* __restrict__ W, int ldw, unsigned char* __restrict__ WT, int kb, int n0, int lane) {
    const int k0 = 128 * kb, kg = lane >> 3, ng = lane & 7;
    const float* src = W + (size_t)(k0 + 16 * kg) * ldw + n0 + 4 * ng;
    f32x4 v[16];
#pragma unroll
    for (int i = 0; i < 16; ++i) v[i] = __builtin_nontemporal_load((const f32x4*)(src + (size_t)i * ldw)) * 64.0f;
    unsigned char* dst = WT + (size_t)(n0 + 4 * ng) * 2048 + k0 + 16 * kg;
#pragma unroll
    for (int j = 0; j < 4; ++j) { int w[4];
#pragma unroll
        for (int q = 0; q < 4; ++q) { w[q] = 0; w[q] = __builtin_amdgcn_cvt_pk_fp8_f32(v[4 * q][j], v[4 * q + 1][j], w[q], false); w[q] = __builtin_amdgcn_cvt_pk_fp8_f32(v[4 * q + 2][j], v[4 * q + 3][j], w[q], true); }
        const u32x4 o = {(unsigned)w[0], (unsigned)w[1], (unsigned)w[2], (unsigned)w[3]};
        if constexpr (WT_SC1) { const __amdgpu_buffer_rsrc_t rs = __builtin_amdgcn_make_buffer_rsrc((void*)WT, 0, 4096 * 2048, 0x00020000);
            __builtin_amdgcn_raw_buffer_store_b128(o, rs, (unsigned)((n0 + 4 * ng + j) * 2048 + k0 + 16 * kg), 0, 16); }
        else __builtin_nontemporal_store(o, (u32x4*)(dst + (size_t)j * 2048)); }
}
__device__ __forceinline__ void cvt_dispatch(const Args& a, unsigned char* ws, int it, int lane) {
    constexpr int I_IN = 32 * 144, I_OUT = 32 * 64;
    int r = it;
    if (r < I_IN) { cvt_item(a.in[I_WIN], IN_COLS, (bf16_t*)(ws + WS_WINT), r, 144, lane); return; } r -= I_IN;
    if (r < I_OUT) { cvt_item(a.in[I_WOUT], DM, (bf16_t*)(ws + WS_WOUTT), r, 64, lane); return; }
}
constexpr int CVT_NITEMS = 32 * 144 + 32 * 64;
__device__ __forceinline__ void p0_phase(const Args& a, Frame& F) {
    float* mod = (float*)(F.ws + WS_MOD);
    for (int wg = F.vcu; wg < 192; wg += F.G) {
        LAS float* sil = (LAS float*)F.lds; LAS float* red = (LAS float*)(F.lds + 24576);
        __syncthreads();
        for (int idx = F.tid; idx < 3 * 2048; idx += NTHR) { const float v = idx < 4096 ? a.in[I_C][idx] : a.in[I_CCTX][idx - 4096]; sil[idx] = v / (1.0f + __expf(-v)); }
        __syncthreads();
        const int kg = F.tid >> 4, cq = F.tid & 15, col = 64 * wg + 4 * cq;
        f32x4 acc[3] = {};
        const float* wp = a.in[I_WMOD] + (size_t)(kg * 64) * 12288 + col;
#pragma unroll 8
        for (int kk = 0; kk < 64; ++kk) { const f32x4 w = __builtin_nontemporal_load((const f32x4*)(wp + (size_t)kk * 12288)); const int k = kg * 64 + kk;
            acc[0] += sil[k] * w; acc[1] += sil[2048 + k] * w; acc[2] += sil[4096 + k] * w; }
#pragma unroll
        for (int r = 0; r < 3; ++r)
#pragma unroll
            for (int j = 0; j < 4; ++j) red[(kg * 3 + r) * 64 + 4 * cq + j] = acc[r][j];
        __syncthreads();
        if (F.tid < 192) { const int r = F.tid >> 6, cc = F.tid & 63; float s = 0.f;
            for (int g = 0; g < 32; ++g) s += red[(g * 3 + r) * 64 + cc];
            mod[r * 12288 + 64 * wg + cc] = s + a.in[I_BMOD][64 * wg + cc]; }
    }
    const int gw = F.vcu * NWAVES + F.wave, NGW = F.G * NWAVES;
    {
        bf16_t* WT = (bf16_t*)(F.ws + WS_WINT) + (size_t)PW * DM;
        for (int idx = F.vcu * NTHR + F.tid; idx < 256 * DM; idx += F.G * NTHR) { const int n = idx >> 11, k = idx & 2047;
            const float v = n < 16 ? a.in[I_WIN][(size_t)k * IN_COLS + C_G + n] : 0.f; WT[idx] = (bf16_t)(cvt_pk_bf16(v, v) & 0xffffu); }
    }
    for (int it = gw; it < CVT_NITEMS; it += NGW) cvt_dispatch(a, F.ws, it, F.lane);
}

__device__ __forceinline__ void p1_phase(const Args& a, Frame& F) {
    const float* mod = (const float*)(F.ws + WS_MOD);
    const int gw = F.vcu * NWAVES + F.wave, NGW = F.G * NWAVES;
    bf16_t* H = (bf16_t*)(F.ws + WS_H);
    for (int R = gw; R < MROWS; R += NGW) {
        const int b = R / ROWS_B, r = R - b * ROWS_B; const bool lat = r < SEQ;
        const float* src = lat ? a.in[I_X] + ((size_t)(b * SEQ + r)) * DM : a.in[I_CTX] + ((size_t)(b * CTXL + r - SEQ)) * DM;
        const float* mrow = mod + (size_t)(lat ? b : 2) * 12288;
        f32x4 v[8]; float ss = 0.f;
#pragma unroll
        for (int j = 0; j < 8; ++j) { v[j] = *(const f32x4*)(src + 4 * F.lane + 256 * j); ss += (v[j].x * v[j].x + v[j].y * v[j].y) + (v[j].z * v[j].z + v[j].w * v[j].w); }
        const float rstd = 1.0f / sqrtf(wave_sum(ss) * (1.0f / DM) + EPS);
#pragma unroll
        for (int j = 0; j < 8; ++j) { const int k = 4 * F.lane + 256 * j;
            const f32x4 g = *(const f32x4*)(a.in[I_GN1] + k), sc = *(const f32x4*)(mrow + 2048 + k), sh = *(const f32x4*)(mrow + k);
            const f32x4 hv = v[j] * rstd * g * (sc + 1.0f) + sh;
            u32x2 w; w.x = cvt_pk_bf16(hv.x, hv.y); w.y = cvt_pk_bf16(hv.z, hv.w);
            *(u32x2*)(H + (size_t)R * DM + k) = w; }
    }
    float* wrs = (float*)(F.ws + WS_WRS);
    for (int idx = F.vcu * NTHR + F.tid; idx < 2 * 65536; idx += F.G * NTHR) { const int b = idx >> 16, k = (idx >> 5) & 2047;
        wrs[idx] = a.in[I_GN2][k] * (1.0f + mod[b * 12288 + 8192 + k]) * a.in[I_WR][idx & 65535]; }
    for (int be = F.vcu; be < 64; be += F.G) {
        const int b = be >> 5, e = be & 31; float s = 0.f;
#pragma unroll
        for (int i = 0; i < 4; ++i) { const int k = F.tid + NTHR * i; s += mod[b * 12288 + 6144 + k] * a.in[I_WR][k * 32 + e]; }
        s = wave_sum(s);
        LAS float* red = (LAS float*)F.lds;
        __syncthreads();
        if (F.lane == 0) red[F.wave] = s;
        __syncthreads();
        if (F.tid == 0) { float t = 0.f; for (int w = 0; w < NWAVES; ++w) t += red[w]; wrs[2 * 65536 + be] = t + a.in[I_BR][e]; }
    }
}

__device__ __forceinline__ float wave_scan_add(float v, int lane) {
#pragma unroll
    for (int o = 1; o < 64; o <<= 1) { const float t = __shfl_up(v, o); if (lane >= o) v += t; }
    return v;
}
__device__ __forceinline__ float wave_scan_max(float v, int lane) {
#pragma unroll
    for (int o = 1; o < 64; o <<= 1) { const float t = __shfl_up(v, o); if (lane >= o) v = fmaxf(v, t); }
    return v;
}
__device__ __forceinline__ float log_sigmoid(float f) { return fminf(f, 0.f) - log1pf(__expf(-fabsf(f))); }
__device__ __forceinline__ void p3_phase(const Args& a, Frame& F) {
    LAS float* cs = (LAS float*)F.lds; LAS float* sn = (LAS float*)(F.lds + 8192);
    LAS float* gi = (LAS float*)(F.lds + 16384); LAS float* gf = (LAS float*)(F.lds + 16384 + 17408);
    __syncthreads();
    for (int idx = F.tid; idx < 2048; idx += NTHR) { const int pos = idx >> 5, fi = idx & 31; const float inv = exp2f(-(float)fi * 0.41524101186092029f); const float ang = (float)pos * inv;
        cs[idx] = cosf(ang); sn[idx] = sinf(ang); }
    const float* gate = (const float*)(F.ws + WS_GATE);
    float* GA = (float*)(F.ws + WS_GA); float* GM = (float*)(F.ws + WS_GM); float* GB = (float*)(F.ws + WS_GB); float* GC = (float*)(F.ws + WS_GC);
    for (int task = F.vcu * NWAVES + F.wave; task < NCHAIN * NTB; task += F.G * NWAVES) {
        const int chain = task / NTB, tb = task - chain * NTB; const int b = chain >> 3, dir = (chain >> 2) & 1, h = chain & 3;
        const int j0 = 2 * F.lane, j1 = j0 + 1;
        const int r0 = tb * 128 + (dir == 0 ? j0 : 127 - j0), r1 = tb * 128 + (dir == 0 ? j1 : 127 - j1);
        const float* g0 = gate + (size_t)(b * ROWS_B + r0) * 16; const float* g1 = gate + (size_t)(b * ROWS_B + r1) * 16;
        const float lf0 = log_sigmoid(g0[8 + dir * 4 + h]), lf1 = log_sigmoid(g1[8 + dir * 4 + h]), i0 = g0[dir * 4 + h], i1 = g1[dir * 4 + h];
        const float s1 = lf0 + lf1; const float incl = wave_scan_add(s1, F.lane), excl = incl - s1;
        const float b0 = excl + lf0, b1 = excl + s1;
        const float a0 = i0 - b0, a1 = i1 - b1; const float m1 = fmaxf(a0, a1);
        const float im = wave_scan_max(m1, F.lane); float ex = __shfl_up(im, 1); if (F.lane == 0) ex = -3.0e38f;
        const float c0 = fmaxf(ex, a0), c1 = fmaxf(ex, m1);
        const size_t o = (size_t)chain * ROWS_B;
        GA[o + r0] = a0; GA[o + r1] = a1; GM[o + r0] = c0; GM[o + r1] = c1; GB[o + r0] = b0; GB[o + r1] = b1;
        if (F.lane == 63) { float* gc = GC + (size_t)(chain * NTB + tb) * 4; gc[0] = b1; gc[1] = c1; }
    }
    __syncthreads();
    bf16_t* P = (bf16_t*)(F.ws + WS_P);
    const int gw = F.vcu * NWAVES + F.wave, NGW = F.G * NWAVES;
    const int sub = F.lane >> 4, l16 = F.lane & 15, e0 = 8 * l16;
    for (int R = gw; R < MROWS; R += NGW) {
        const int b = R / ROWS_B, r = R - b * ROWS_B; const bool lat = r < SEQ;
        u32x4 raws[3]; bool act[3]; bf16_t* ptr[3];
#pragma unroll
        for (int step = 0; step < 3; ++step) {
            const int s_ = step * 4 + sub; const bool isq = s_ < 8; act[step] = isq ? lat : (s_ < 10);
            const int colb = isq ? s_ * 128 : C_K + (s_ - 8) * 128;
            ptr[step] = P + (size_t)R * PW + colb + e0;
            raws[step] = (u32x4){0u, 0u, 0u, 0u}; if (act[step]) raws[step] = *(const u32x4*)ptr[step];
        }
#pragma unroll
        for (int step = 0; step < 3; ++step) {
            const int s_ = step * 4 + sub; const bool isq = s_ < 8; const u32x4 raw = raws[step];
            float y[8]; y[0] = bflo(raw.x); y[1] = bfhi(raw.x); y[2] = bflo(raw.y); y[3] = bfhi(raw.y); y[4] = bflo(raw.z); y[5] = bfhi(raw.z); y[6] = bflo(raw.w); y[7] = bfhi(raw.w);
            float ss = 0.f;
#pragma unroll
            for (int i = 0; i < 8; ++i) ss += y[i] * y[i];
            ss += __shfl_xor(ss, 1); ss += __shfl_xor(ss, 2); ss += __shfl_xor(ss, 4); ss += __shfl_xor(ss, 8);
            const float rstd = 1.0f / sqrtf(ss * (1.0f / HD) + EPS);
            const float* g = (isq ? a.in[I_GQ] : a.in[I_GK]) + e0;
#pragma unroll
            for (int i = 0; i < 8; ++i) y[i] = y[i] * rstd * g[i];
            if (lat) {
                const int posr = r >> 6, posc = r & 63;
#pragma unroll
                for (int i = 0; i < 4; ++i) { const int pp = 4 * l16 + i; const int pos = pp < 32 ? posr : posc; const int ti = pos * 32 + (pp & 31);
                    const float c = cs[ti], sv = sn[ti]; const float x1 = y[2 * i], x2 = y[2 * i + 1]; y[2 * i] = x1 * c - x2 * sv; y[2 * i + 1] = x1 * sv + x2 * c; }
            }
            if (act[step]) { u32x4 w; w.x = cvt_pk_bf16(y[0], y[1]); w.y = cvt_pk_bf16(y[2], y[3]); w.z = cvt_pk_bf16(y[4], y[5]); w.w = cvt_pk_bf16(y[6], y[7]); *(u32x4*)ptr[step] = w; }
        }
    }
}

__device__ __forceinline__ int chain_tb(int dir, int c) { return dir == 0 ? (c < 2 ? 32 + c : c - 2) : 33 - c; }
__device__ __forceinline__ int chain_pos(int dir, int tb) { return dir == 0 ? (tb < 32 ? tb + 2 : tb - 32) : 33 - tb; }
__device__ __forceinline__ void chain_scan(const float* GC, int chain, int dir, int lane, float& mp_c, float& am_c) {
    const int c = lane < NTB ? lane : NTB - 1; const float* gc = GC + (size_t)(chain * NTB + chain_tb(dir, c)) * 4;
    const float x = gc[0], y = gc[1]; float m = 0.f, mp = 0.f;
#pragma unroll
    for (int i = 0; i < NTB; ++i) { if (lane == i) mp = m; m = __shfl(x, i) + fmaxf(m, __shfl(y, i)); }
    mp_c = mp; am_c = y;
}

__device__ __forceinline__ void p4_phase(const Args& a, Frame& F) {
    using namespace att;
    const bf16_t* P = (const bf16_t*)(F.ws + WS_P);
    const float* GA = (const float*)(F.ws + WS_GA); const float* GC = (const float*)(F.ws + WS_GC);
    float* LST = (float*)(F.ws + WS_LST); float* NL = (float*)(F.ws + WS_NL);
    char* Vimg = F.ldsg; char* Kimg = F.ldsg + 65536; LAS float* wsc = (LAS float*)(F.lds + TAB_OFF);
    for (int u = F.vcu; u < NB * MH * NTB; u += F.G) {
        const int b = u / (MH * NTB), h = (u / NTB) % MH, tb = u % NTB;
        int tid = F.tid; asm volatile("" : "+v"(tid));
        const int lane = tid & 63, r32 = lane & 31, hi = lane >> 5;
        const size_t rowbase = (size_t)b * ROWS_B + tb * 128;
        __syncthreads();
        if (F.wave < 2) { const int dir = F.wave, chain = (b * 2 + dir) * 4 + h; float mp, am; chain_scan(GC, chain, dir, lane, mp, am);
            if (lane == chain_pos(dir, tb)) wsc[256 + dir] = fmaxf(mp, am); }
        __syncthreads();
        if (tid < 256) { const int dir = tid >> 7, s = tid & 127; const int chain = (b * 2 + dir) * 4 + h;
            wsc[tid] = 0.088388347648318440f * __expf(GA[(size_t)chain * ROWS_B + tb * 128 + s] - wsc[256 + dir]); }
        __syncthreads();
#pragma unroll
        for (int i = 0; i < 8; ++i) { const int p = tid + NTHR * i, s = p >> 5, c8 = (p & 31) * 8;
            const bf16x8 v = *(const bf16x8*)(P + (rowbase + s) * PW + C_MV + h * 256 + c8);
            *(bf16x8*)(Vimg + ((s >> 6) * 2 + (c8 >> 7)) * 16384 + v_st(s & 63, c8 & 127)) = v; }
#pragma unroll
        for (int i = 0; i < 4; ++i) { const int p = tid + NTHR * i, s = p >> 4, c8 = (p & 15) * 8;
            const u32x4 raw = *(const u32x4*)(P + (rowbase + s) * PW + C_MK + h * 128 + c8);
            float y[8]; y[0] = bflo(raw.x); y[1] = bfhi(raw.x); y[2] = bflo(raw.y); y[3] = bfhi(raw.y); y[4] = bflo(raw.z); y[5] = bfhi(raw.z); y[6] = bflo(raw.w); y[7] = bfhi(raw.w);
#pragma unroll
            for (int dir = 0; dir < 2; ++dir) { const float w = wsc[dir * 128 + s];
                u32x4 o; o.x = cvt_pk_bf16(y[0] * w, y[1] * w); o.y = cvt_pk_bf16(y[2] * w, y[3] * w); o.z = cvt_pk_bf16(y[4] * w, y[5] * w); o.w = cvt_pk_bf16(y[6] * w, y[7] * w);
                *(u32x4*)(Kimg + (dir * 2 + (s >> 6)) * 16384 + v_st(s & 63, c8)) = o; } }
        __syncthreads();
        const int vh = F.wave >> 2, vb = F.wave & 3;
        f32x16 acc[2][4];
#pragma unroll
        for (int d = 0; d < 2; ++d)
#pragma unroll
            for (int q = 0; q < 4; ++q) acc[d][q] = f32x16{};
#pragma unroll
        for (int kt = 0; kt < 2; ++kt) {
            const int baseA = (int)(uintptr_t)Vimg + (kt * 2 + vh) * 16384 + vb * 512 + v_rd_base(lane);
            const int baseB0 = (int)(uintptr_t)Kimg + (0 * 2 + kt) * 16384 + v_rd_base(lane);
            const int baseB1 = (int)(uintptr_t)Kimg + (1 * 2 + kt) * 16384 + v_rd_base(lane);
#define P4_STEP(KS) do { \
            const s16x4 al = tr_read<v_rd_off(0, KS, 0)>(baseA), ah = tr_read<v_rd_off(0, KS, 1)>(baseA); \
            const s16x4 b00l = tr_read<v_rd_off(0, KS, 0)>(baseB0), b00h = tr_read<v_rd_off(0, KS, 1)>(baseB0), b01l = tr_read<v_rd_off(1, KS, 0)>(baseB0), b01h = tr_read<v_rd_off(1, KS, 1)>(baseB0); \
            const s16x4 b02l = tr_read<v_rd_off(2, KS, 0)>(baseB0), b02h = tr_read<v_rd_off(2, KS, 1)>(baseB0), b03l = tr_read<v_rd_off(3, KS, 0)>(baseB0), b03h = tr_read<v_rd_off(3, KS, 1)>(baseB0); \
            const s16x4 b10l = tr_read<v_rd_off(0, KS, 0)>(baseB1), b10h = tr_read<v_rd_off(0, KS, 1)>(baseB1), b11l = tr_read<v_rd_off(1, KS, 0)>(baseB1), b11h = tr_read<v_rd_off(1, KS, 1)>(baseB1); \
            const s16x4 b12l = tr_read<v_rd_off(2, KS, 0)>(baseB1), b12h = tr_read<v_rd_off(2, KS, 1)>(baseB1), b13l = tr_read<v_rd_off(3, KS, 0)>(baseB1), b13h = tr_read<v_rd_off(3, KS, 1)>(baseB1); \
            asm volatile("s_waitcnt lgkmcnt(0)" ::: "memory"); SBAR(); \
            const bf16x8 af = PKLH(al, ah); \
            acc[0][0] = __builtin_amdgcn_mfma_f32_32x32x16_bf16(af, PKLH(b00l, b00h), acc[0][0], 0, 0, 0); acc[0][1] = __builtin_amdgcn_mfma_f32_32x32x16_bf16(af, PKLH(b01l, b01h), acc[0][1], 0, 0, 0); \
            acc[0][2] = __builtin_amdgcn_mfma_f32_32x32x16_bf16(af, PKLH(b02l, b02h), acc[0][2], 0, 0, 0); acc[0][3] = __builtin_amdgcn_mfma_f32_32x32x16_bf16(af, PKLH(b03l, b03h), acc[0][3], 0, 0, 0); \
            acc[1][0] = __builtin_amdgcn_mfma_f32_32x32x16_bf16(af, PKLH(b10l, b10h), acc[1][0], 0, 0, 0); acc[1][1] = __builtin_amdgcn_mfma_f32_32x32x16_bf16(af, PKLH(b11l, b11h), acc[1][1], 0, 0, 0); \
            acc[1][2] = __builtin_amdgcn_mfma_f32_32x32x16_bf16(af, PKLH(b12l, b12h), acc[1][2], 0, 0, 0); acc[1][3] = __builtin_amdgcn_mfma_f32_32x32x16_bf16(af, PKLH(b13l, b13h), acc[1][3], 0, 0, 0); \
        } while (0)
            P4_STEP(0); P4_STEP(1); P4_STEP(2); P4_STEP(3);
#undef P4_STEP
        }
#pragma unroll
        for (int dir = 0; dir < 2; ++dir) { const int chain = (b * 2 + dir) * 4 + h; float* Lp = LST + ((size_t)(chain * NTB + tb) * 256 + 32 * F.wave) * 128;
#pragma unroll
            for (int q = 0; q < 4; ++q)
#pragma unroll
                for (int rr = 0; rr < 16; ++rr) Lp[(size_t)crow(rr, hi) * 128 + 32 * q + r32] = acc[dir][q][rr]; }
        if (tid < 256) { const int dir = tid >> 7, d = tid & 127; const int chain = (b * 2 + dir) * 4 + h; float s = 0.f;
            for (int ss = 0; ss < 128; ++ss) s += bf2f(*(const unsigned short*)(Kimg + (dir * 2 + (ss >> 6)) * 16384 + v_st(ss & 63, d & ~7) + (d & 7) * 2));
            NL[(size_t)(chain * NTB + tb) * 128 + d] = s; }
    }
    __syncthreads();
}

__device__ __forceinline__ void p5_phase(const Args& a, Frame& F) {
    const float* __restrict__ LST = (const float*)(F.ws + WS_LST); const float* __restrict__ NL = (const float*)(F.ws + WS_NL); const float* __restrict__ GC = (const float*)(F.ws + WS_GC);
    bf16_t* __restrict__ CST = (bf16_t*)(F.ws + WS_CST); float* __restrict__ NST = (float*)(F.ws + WS_NST);
    for (int u = F.vcu; u < NCHAIN * 16; u += F.G) {
        const int chain = u >> 4, part = u & 15, dir = (chain >> 2) & 1; const size_t e0 = (size_t)part * 2048 + F.tid * 4;
        LAS float* dec_l = (LAS float*)F.lds;
        __syncthreads();
        if (F.wave == 0) { float mp, am; chain_scan(GC, chain, dir, F.lane, mp, am); if (F.lane < NTB) dec_l[F.lane] = __expf(mp - fmaxf(mp, am)); }
        __syncthreads();
        f32x4 C = {0.f, 0.f, 0.f, 0.f}; float n = 0.f; const bool don = (part == 0 && F.tid < 128);
#pragma unroll 2
        for (int c = 0; c < NTB; ++c) {
            const int tb = dir == 0 ? (c < 2 ? 32 + c : c - 2) : 33 - c;
            if (tb < 32) { u32x2 w; w.x = cvt_pk_bf16(C.x, C.y); w.y = cvt_pk_bf16(C.z, C.w); *(u32x2*)(CST + (size_t)(chain * 32 + tb) * 32768 + e0) = w;
                if (don) NST[(size_t)(chain * 32 + tb) * 128 + F.tid] = n; }
            if (c < NTB - 1) { const float dec = dec_l[c];
                const f32x4 L = *(const f32x4*)(LST + (size_t)(chain * NTB + tb) * 32768 + e0); C = dec * C + L;
                if (don) n = dec * n + NL[(size_t)(chain * NTB + tb) * 128 + F.tid]; }
        }
    }
}

__device__ __forceinline__ void p6_attention(const Args& a, Frame& F) {
    const bf16_t* P = (const bf16_t*)(F.ws + WS_P); bf16_t* Y = (bf16_t*)(F.ws + WS_Y);
    for (int u = F.vcu; u < 256; u += F.G) {
        const int x = u >> 5, idx = u & 31, b = x >> 2, kvh = (x >> 1) & 1, qhalf = x & 1, g = idx >> 3, qblk = qhalf * 8 + (idx & 7), head = kvh * 4 + g;
        const bf16_t* Qb = P + ((size_t)b * ROWS_B + qblk * 256) * PW + C_Q + head * 128;
        const bf16_t* Kh = P + ((size_t)b * ROWS_B) * PW + C_K + kvh * 128;
        const bf16_t* Vh = P + ((size_t)b * ROWS_B) * PW + C_V + kvh * 128;
        bf16_t* Ob = Y + ((size_t)b * SEQ + qblk * 256) * DM + head * 128;
        __syncthreads();
        att::attn_dense_body<PW, PW, DM>(Qb, Kh, Vh, Ob, ROWS_B, F.ldsg);
    }
}
__device__ __forceinline__ void p6_mlstm_out(const Args& a, Frame& F) {
    using namespace att;
    const bf16_t* P = (const bf16_t*)(F.ws + WS_P); bf16_t* Y = (bf16_t*)(F.ws + WS_Y);
    const float* GA = (const float*)(F.ws + WS_GA); const float* GM = (const float*)(F.ws + WS_GM); const float* GB = (const float*)(F.ws + WS_GB); const float* GC = (const float*)(F.ws + WS_GC);
    const bf16_t* CST = (const bf16_t*)(F.ws + WS_CST); const float* NST = (const float*)(F.ws + WS_NST);
    char* Vimg = F.ldsg; char* Kimg = F.ldsg + 65536;
    LAS float* ga_l = (LAS float*)(F.lds + 98304);
    LAS float* nst_l = (LAS float*)(F.lds + 98304 + 1024);
    LAS float* xw = (LAS float*)(F.lds + 98304 + 2048);
    LAS float* ssx = (LAS float*)(F.lds + 98304 + 4096);
    LAS float* mpv = (LAS float*)(F.lds + 98304 + 5120);
    const int wq = F.wave & 1, vq = F.wave >> 1, vh = vq >> 1, vsub = vq & 1;
    LAS float* myx = xw + F.wave * 64;
    for (int u = F.vcu; u < NB * MH * 32 * 2; u += F.G) {
        const int b = u >> 8, h = (u >> 6) & 3, lb = (u >> 1) & 31, rh = u & 1;
        int tid = F.tid; asm volatile("" : "+v"(tid));
        const int lane = tid & 63, r32 = lane & 31, hi = lane >> 5;
        const size_t rowbase = (size_t)b * ROWS_B + lb * 128;
        __syncthreads();
#pragma unroll
        for (int i = 0; i < 8; ++i) { const int p = tid + NTHR * i, s = p >> 5, c8 = (p & 31) * 8;
            const bf16x8 v = *(const bf16x8*)(P + (rowbase + s) * PW + C_MV + h * 256 + c8);
            *(bf16x8*)(Vimg + ((s >> 6) * 2 + (c8 >> 7)) * 16384 + v_st(s & 63, c8 & 127)) = v; }
#pragma unroll
        for (int i = 0; i < 4; ++i) { const int p = tid + NTHR * i, s = p >> 4, c8 = (p & 15) * 8;
            const bf16x8 v = *(const bf16x8*)(P + (rowbase + s) * PW + C_MK + h * 128 + c8);
            *(bf16x8*)(Kimg + (s >> 6) * 16384 + KSWZ(s & 63, c8 * 2)) = v; }
        if (tid < 256) { const int dir = tid >> 7, s = tid & 127; const int chain = (b * 2 + dir) * 4 + h;
            ga_l[tid] = GA[(size_t)chain * ROWS_B + lb * 128 + s]; nst_l[tid] = NST[(size_t)(chain * 32 + lb) * 128 + s]; }
        if (F.wave < 2) { const int dir = F.wave, chain = (b * 2 + dir) * 4 + h; float mp, am; chain_scan(GC, chain, dir, lane, mp, am);
            if (lane == chain_pos(dir, lb)) mpv[dir] = mp; }
        const int t = rh * 64 + wq * 32 + r32;
        bf16x8 qr[8];
        { const bf16_t* Qw = P + (rowbase + t) * PW + C_MQ + h * 128 + hi * 8;
#pragma unroll
          for (int d0 = 0; d0 < 8; ++d0) qr[d0] = *reinterpret_cast<const bf16x8*>(Qw + d0 * 16); }
        __syncthreads();
        f32x16 hsum[2];
        hsum[0] = f32x16{}; hsum[1] = f32x16{};
#pragma unroll 1
        for (int dir = 0; dir < 2; ++dir) {
            const int chain = (b * 2 + dir) * 4 + h;
            const float mprev = mpv[dir];
            const float Mt = fmaxf(mprev, GM[(size_t)chain * ROWS_B + lb * 128 + t]), bt = GB[(size_t)chain * ROWS_B + lb * 128 + t];
            const float winter = __expf(mprev - Mt);
            f32x16 o[2]; o[0] = f32x16{}; o[1] = f32x16{};
            const bf16_t* Cb = CST + ((size_t)(chain * 32 + lb) * 256 + vq * 64 + r32) * 128 + hi * 8;
#pragma unroll
            for (int ds = 0; ds < 8; ++ds) {
#pragma unroll
                for (int q = 0; q < 2; ++q) { const bf16x8 cf = *reinterpret_cast<const bf16x8*>(Cb + (size_t)q * 32 * 128 + ds * 16);
                    o[q] = __builtin_amdgcn_mfma_f32_32x32x16_bf16(qr[ds], cf, o[q], 0, 0, 0); }
                if (ds == 3) asm volatile("" ::: "memory"); }
            float qn = 0.f;
#pragma unroll
            for (int ds = 0; ds < 8; ++ds)
#pragma unroll
                for (int j = 0; j < 8; ++j) qn += bf2f((unsigned short)qr[ds][j]) * nst_l[dir * 128 + ds * 16 + hi * 8 + j];
            { auto rr = __builtin_amdgcn_permlane32_swap(__float_as_uint(qn), __float_as_uint(qn), false, false); qn = __uint_as_float(rr[0]) + __uint_as_float(rr[1]); }
            if (hi == 0) myx[r32] = winter;
            LDS_WAIT();
#pragma unroll
            for (int rr = 0; rr < 16; ++rr) { const float w = myx[crow(rr, hi)]; o[0][rr] *= w; o[1][rr] *= w; }
            float rowsum = 0.f;
            int tt = t; asm volatile("" : "+v"(tt));
#pragma unroll
            for (int kt = 0; kt < 2; ++kt) {
                f32x16 p0, p1;
                qkt(p0, p1, Kimg + kt * 16384, qr, r32, hi);
#pragma unroll
                for (int rr = 0; rr < 16; ++rr) {
                    const int s0 = kt * 64 + crow(rr, hi), s1 = s0 + 32;
                    const bool ok0 = dir == 0 ? (s0 <= tt) : (s0 >= tt), ok1 = dir == 0 ? (s1 <= tt) : (s1 >= tt);
                    const float e0 = __expf(ga_l[dir * 128 + s0] - Mt), e1 = __expf(ga_l[dir * 128 + s1] - Mt);
                    p0[rr] = ok0 ? p0[rr] * 0.088388347648318440f * e0 : 0.f; p1[rr] = ok1 ? p1[rr] * 0.088388347648318440f * e1 : 0.f;
                    rowsum += p0[rr] + p1[rr];
                }
                bf16x8 pa0, pa1, pa2, pa3;
                PK4(p0, 0, pa0); PK4(p0, 8, pa1); PK4(p1, 0, pa2); PK4(p1, 8, pa3);
                const int vbase = (int)(uintptr_t)Vimg + (kt * 2 + vh) * 16384 + vsub * 1024 + v_rd_base(lane);
                pv_one<0>(o[0], vbase, pa0, pa1, pa2, pa3); pv_one<1>(o[1], vbase, pa0, pa1, pa2, pa3);
            }
            { auto rr = __builtin_amdgcn_permlane32_swap(__float_as_uint(rowsum), __float_as_uint(rowsum), false, false); rowsum = __uint_as_float(rr[0]) + __uint_as_float(rr[1]); }
            const float den = rowsum + winter * qn;
            const float rinv = 1.0f / fmaxf(fabsf(den), __expf(-(bt + Mt)));
            LDS_WAIT();
            if (hi == 0) myx[32 + r32] = rinv;
            LDS_WAIT();
#pragma unroll
            for (int rr = 0; rr < 16; ++rr) { const float w = myx[32 + crow(rr, hi)]; hsum[0][rr] += o[0][rr] * w; hsum[1][rr] += o[1][rr] * w; }
        }
        float ssr[16];
#pragma unroll
        for (int rr = 0; rr < 16; ++rr) { float s = hsum[0][rr] * hsum[0][rr] + hsum[1][rr] * hsum[1][rr];
            s += __shfl_xor(s, 1); s += __shfl_xor(s, 2); s += __shfl_xor(s, 4); s += __shfl_xor(s, 8); s += __shfl_xor(s, 16); ssr[rr] = s; }
        if (r32 == 0) {
#pragma unroll
            for (int rr = 0; rr < 16; ++rr) ssx[vq * 64 + wq * 32 + crow(rr, hi)] = ssr[rr]; }
        __syncthreads();
        const float* gml = a.in[I_GML] + h * 256 + vq * 64 + r32;
        const float g0 = gml[0], g1 = gml[32];
#pragma unroll
        for (int rr = 0; rr < 16; ++rr) { const int row = wq * 32 + crow(rr, hi);
            const float rn = 1.0f / sqrtf(((ssx[row] + ssx[64 + row]) + (ssx[128 + row] + ssx[192 + row])) * (1.0f / MDV) + EPS);
            const size_t prow = rowbase + rh * 64 + row; const size_t yrow = (size_t)b * SEQ + lb * 128 + rh * 64 + row;
#pragma unroll
            for (int q = 0; q < 2; ++q) { const int v = vq * 64 + 32 * q + r32;
                const float mo = bf2f(P[prow * PW + C_MO + h * 256 + v]);
                const float val = hsum[q][rr] * rn * (q == 0 ? g0 : g1) / (1.0f + __expf(-mo));
                Y[yrow * DM + 1024 + h * 256 + v] = (bf16_t)(cvt_pk_bf16(val, val) & 0xffffu); } }
    }
    __syncthreads();
}

__device__ __forceinline__ void p8_phase(const Args& a, Frame& F) {
    using att::crow;
    const float* X1 = (const float*)(F.ws + WS_X1); const float* mod = (const float*)(F.ws + WS_MOD);
    const float* wrs = (const float*)(F.ws + WS_WRS);
    unsigned char* H2 = F.ws + WS_H;
    int* TOKE = (int*)(F.ws + WS_TOKE); int* TOKP = (int*)(F.ws + WS_TOKP); float* TOKW = (float*)(F.ws + WS_TOKW); int* LIST = (int*)(F.ws + WS_LIST);
    unsigned* ctl = (unsigned*)(F.ws + WS_CTL);
    LAS float* PL = (LAS float*)F.lds;
    LAS float* PSS = (LAS float*)(F.lds + 32768);
    LAS int* hist = (LAS int*)(F.lds + 32768 + 2048);
    LAS int* basee = hist + 32;
    LAS float* rstd_l = (LAS float*)(hist + 64);
    LAS int* selE = hist + 96; LAS int* selR = hist + 96 + 128; LAS float* selW = (LAS float*)(hist + 96 + 256);
    const int r32 = F.lane & 31, hi = F.lane >> 5;
    for (int blk = F.vcu; blk < NLAT / 32; blk += F.G) {
        const int tok0 = blk * 32, b = tok0 >> 12;
        const float* Wp = wrs + (size_t)b * 65536; const float* cb = wrs + 2 * 65536 + b * 32;
        __syncthreads();
        if (F.tid < 32) hist[F.tid] = 0;
        { const int k0 = 256 * F.wave; f32x16 acc = {}; float ssq = 0.f;
          const float* xr = X1 + (size_t)(tok0 + r32) * DM + k0 + 4 * hi;
#pragma unroll 4
          for (int q = 0; q < 32; ++q) { const f32x4 a4 = *(const f32x4*)(xr + 8 * q); const float* wq_ = Wp + (size_t)(k0 + 8 * q + 4 * hi) * 32 + r32;
              const float b0 = wq_[0], b1 = wq_[32], b2 = wq_[64], b3 = wq_[96];
              ssq += (a4.x * a4.x + a4.y * a4.y) + (a4.z * a4.z + a4.w * a4.w);
              acc = __builtin_amdgcn_mfma_f32_32x32x2f32(a4.x, b0, acc, 0, 0, 0); acc = __builtin_amdgcn_mfma_f32_32x32x2f32(a4.y, b1, acc, 0, 0, 0);
              acc = __builtin_amdgcn_mfma_f32_32x32x2f32(a4.z, b2, acc, 0, 0, 0); acc = __builtin_amdgcn_mfma_f32_32x32x2f32(a4.w, b3, acc, 0, 0, 0); }
#pragma unroll
          for (int rr = 0; rr < 16; ++rr) PL[(F.wave * 32 + crow(rr, hi)) * 32 + r32] = acc[rr];
          PSS[F.wave * 64 + F.lane] = ssq; }
        __syncthreads();
#pragma unroll 1
        for (int rr = 0; rr < 4; ++rr) { const int row = 4 * F.wave + rr; float sum = 0.f, ss = 0.f;
#pragma unroll
            for (int ww = 0; ww < 8; ++ww) { sum += PL[(ww * 32 + row) * 32 + r32]; ss += PSS[ww * 64 + row] + PSS[ww * 64 + 32 + row]; }
            const float rstd = 1.0f / sqrtf(ss * (1.0f / DM) + EPS);
            float v = rstd * sum + cb[r32];
            float vals[4]; int ids[4];
#pragma unroll
            for (int k = 0; k < 4; ++k) { float m = v;
#pragma unroll
                for (int o = 1; o < 64; o <<= 1) m = fmaxf(m, __shfl_xor(m, o));
                const unsigned long long bal = __ballot(v == m); const int idx = (int)__builtin_ctzll(bal) & 31;
                vals[k] = m; ids[k] = idx; if (r32 == idx) v = -3.0e38f; }
            const float e1 = __expf(vals[1] - vals[0]), e2 = __expf(vals[2] - vals[0]), e3 = __expf(vals[3] - vals[0]); const float inv = 1.0f / (1.0f + e1 + e2 + e3);
            if (F.lane < 4) { const int myid = F.lane == 0 ? ids[0] : F.lane == 1 ? ids[1] : F.lane == 2 ? ids[2] : ids[3];
                const float myw = (F.lane == 0 ? 1.0f : F.lane == 1 ? e1 : F.lane == 2 ? e2 : e3) * inv;
                const int rank = __hip_atomic_fetch_add(&hist[myid], 1, __ATOMIC_RELAXED, __HIP_MEMORY_SCOPE_WORKGROUP);
                selE[row * 4 + F.lane] = myid; selR[row * 4 + F.lane] = rank; selW[row * 4 + F.lane] = myw; }
            if (F.lane == 0) rstd_l[row] = rstd; }
        __syncthreads();
        if (F.tid < 32) basee[F.tid] = (int)__hip_atomic_fetch_add(ctl + CW_CNT + 64 * F.tid, (unsigned)hist[F.tid], __ATOMIC_RELAXED, __HIP_MEMORY_SCOPE_AGENT);
        __syncthreads();
        if (F.tid < 128) { const int row = F.tid >> 2; const int e = selE[F.tid]; const int pos = basee[e] + selR[F.tid]; const int tok = tok0 + row;
            LIST[e * 8192 + pos] = tok; TOKE[tok * 4 + (F.tid & 3)] = e; TOKP[tok * 4 + (F.tid & 3)] = pos; TOKW[tok * 4 + (F.tid & 3)] = selW[F.tid]; }
        const float* mrow = mod + (size_t)b * 12288;
#pragma unroll 1
        for (int rr = 0; rr < 4; ++rr) { const int row = 4 * F.wave + rr, tok = tok0 + row; const float rstd = rstd_l[row];
#pragma unroll
            for (int j = 0; j < 8; ++j) { const int k = 4 * F.lane + 256 * j; const f32x4 v = *(const f32x4*)(X1 + (size_t)tok * DM + k);
                const f32x4 g = *(const f32x4*)(a.in[I_GN2] + k), sc = *(const f32x4*)(mrow + 8192 + k), sh = *(const f32x4*)(mrow + 6144 + k);
                const f32x4 hv = v * rstd * g * (sc + 1.0f) + sh;
                int w = 0; w = __builtin_amdgcn_cvt_pk_fp8_f32(hv.x, hv.y, w, false); w = __builtin_amdgcn_cvt_pk_fp8_f32(hv.z, hv.w, w, true); *(int*)(H2 + (size_t)tok * DM + k) = w; } }
    }
    __syncthreads();
}

__device__ __forceinline__ void build_etab(Frame& F) {
    unsigned* ctl = (unsigned*)(F.ws + WS_CTL); LAS int* et = (LAS int*)(F.lds + ETAB_OFF);
    __syncthreads();
    if (F.wave == 0) { const int e = F.lane & 31; const int cnt = (int)__hip_atomic_load(ctl + CW_CNT + 64 * e, __ATOMIC_RELAXED, __HIP_MEMORY_SCOPE_AGENT); const int tiles = (cnt + 255) >> 8;
        int incl = tiles;
#pragma unroll
        for (int o = 1; o < 32; o <<= 1) { const int t = __shfl_up(incl, o); if (e >= o) incl += t; }
        const unsigned long long nzm = __ballot(tiles > 0 && F.lane < 32);
        if (F.lane < 32) { et[e] = cnt; et[32 + e] = tiles; et[64 + e] = incl - tiles; if (e == 31) et[64 + 32] = incl;
            const int rk = __builtin_popcountll(nzm & ((1ull << e) - 1ull)); et[128 + e] = rk; if (tiles > 0) et[160 + rk] = e; if (e == 0) et[192] = __builtin_popcountll(nzm); } }
    __syncthreads();
}
__device__ __forceinline__ void moe_converter(const Args& a, Frame& F, int cw, int ncw, int gG) {
    LAS const int* et = (LAS const int*)(F.lds + ETAB_OFF); LAS int* xt = (LAS int*)F.lds;
    unsigned* ctl = (unsigned*)(F.ws + WS_CTL);
    if (F.wave == 0) {
        const int x = F.lane & 7; const int nunits = et[64 + 32] * 16; const int q = nunits / 8, r = nunits % 8;
        const int start = x < r ? x * (q + 1) : r * (q + 1) + (x - r) * q, len = x < r ? q + 1 : q;
        int dlo = 0, dhi = -1;
        if (len > 0) {
#pragma unroll 1
            for (int which = 0; which < 2; ++which) { const int wg = which ? start + len - 1 : start; int e = 0;
                for (int ee = 0; ee < 32; ++ee) if (et[32 + ee] > 0 && et[64 + ee] * 16 <= wg) e = ee;
                const int d = et[128 + e] * 16 + (wg - et[64 + e] * 16) / et[32 + e]; if (which) dhi = d; else dlo = d; } }
        const int dlo_next = __shfl(dlo, (F.lane + 1) & 63), len_next = __shfl(len, (F.lane + 1) & 63);
        if (x < 7 && len > 0 && len_next > 0 && dhi == dlo_next) dhi -= 1;
        const int n = dhi - dlo + 1 > 0 ? dhi - dlo + 1 : 0; int mx = n;
#pragma unroll
        for (int o = 1; o < 8; o <<= 1) mx = max(mx, __shfl_xor(mx, o));
        if (F.lane < 8) { xt[x] = dlo; xt[8 + x] = n; if (x == 0) xt[16] = mx; } }
    __syncthreads();
    const int rmax = __builtin_amdgcn_readfirstlane(xt[16]);
    for (int g = cw; g < rmax * 8 * 128; g += ncw) {
        const int t = g >> 7, sub = g & 127, x = t & 7, r = t >> 3;
        if (r >= __builtin_amdgcn_readfirstlane(xt[8 + x])) continue;
        const int d = __builtin_amdgcn_readfirstlane(xt[x]) + r, e = __builtin_amdgcn_readfirstlane(et[160 + (d >> 4)]), nt = d & 15, kb = sub >> 3, nbl = sub & 7;
        const int n0 = nbl < 4 ? nt * 128 + 32 * nbl : 2048 + nt * 128 + 32 * (nbl - 4);
        cvt_item8<true>(a.in[I_W1] + (size_t)e * 2048 * 4096, 4096, F.ws + WS_W1T + (size_t)e * 4096 * 2048, kb, n0, F.lane);
        asm volatile("s_waitcnt vmcnt(0)" ::: "memory");
        if (F.lane == 0) __hip_atomic_fetch_add(ctl + CW_FLAG + 64 * (e * 16 + nt), 1u, __ATOMIC_RELAXED, __HIP_MEMORY_SCOPE_AGENT);
    }
    for (int g = cw; g < 32 * 16 * 64; g += ncw) { const int e = g >> 10, it = g & 1023;
        cvt_item8<false>(a.in[I_W2] + (size_t)e * 2048 * 2048, 2048, F.ws + WS_W2T + (size_t)e * 2048 * 2048, it >> 6, 32 * (it & 63), F.lane); }
}

__device__ __forceinline__ void p11_phase(const Args& a, Frame& F) {
    const float* X1 = (const float*)(F.ws + WS_X1); const float* mod = (const float*)(F.ws + WS_MOD); const bf16_t* YB = (const bf16_t*)(F.ws + WS_YB);
    const int* TOKE = (const int*)(F.ws + WS_TOKE); const int* TOKP = (const int*)(F.ws + WS_TOKP); const float* TOKW = (const float*)(F.ws + WS_TOKW);
    LAS const int* et = (LAS const int*)(F.lds + ETAB_OFF);
    build_etab(F);
    const int gw = F.vcu * NWAVES + F.wave, NGW = F.G * NWAVES;
    for (int tok = gw; tok < NLAT; tok += NGW) {
        const int b = tok >> 12; const float* gt2 = mod + (size_t)b * 12288 + 10240;
        const bf16_t* yr[4]; float w[4];
#pragma unroll
        for (int k = 0; k < 4; ++k) { const int e = TOKE[tok * 4 + k]; const int prow = et[64 + e] * 256 + TOKP[tok * 4 + k]; yr[k] = YB + (size_t)prow * DM; w[k] = TOKW[tok * 4 + k]; }
        f32x4 x2[8]; float ss = 0.f;
#pragma unroll
        for (int j = 0; j < 8; ++j) { const int kk = 4 * F.lane + 256 * j; f32x4 s = {0.f, 0.f, 0.f, 0.f};
#pragma unroll
            for (int k = 0; k < 4; ++k) { const u32x2 y = *(const u32x2*)(yr[k] + kk); s.x += w[k] * bflo(y.x); s.y += w[k] * bfhi(y.x); s.z += w[k] * bflo(y.y); s.w += w[k] * bfhi(y.y); }
            x2[j] = *(const f32x4*)(X1 + (size_t)tok * DM + kk) + *(const f32x4*)(gt2 + kk) * s;
            ss += (x2[j].x * x2[j].x + x2[j].y * x2[j].y) + (x2[j].z * x2[j].z + x2[j].w * x2[j].w); }
        const float rstd = 1.0f / sqrtf(wave_sum(ss) * (1.0f / DM) + EPS);
#pragma unroll
        for (int j = 0; j < 8; ++j) { const int kk = 4 * F.lane + 256 * j; *(f32x4*)(a.out + (size_t)tok * DM + kk) = x2[j] * rstd * *(const f32x4*)(a.in[I_GF] + kk); }
    }
}

constexpr int NPHASE = 12;
#ifndef DUP_PHASE
#define DUP_PHASE -1
#endif
template <int PH> __device__ __forceinline__ void run_phase(const Args& args, Frame& F) {
    { int t_ = threadIdx.x; asm volatile("" : "+v"(t_)); F.tid = t_; F.lane = t_ & 63; }
    if constexpr (PH == 0) p0_phase(args, F);
    if constexpr (PH == 1) p1_phase(args, F);
    if constexpr (PH == 2) {
        gx::PlainSched S; S.init(F.ws + WS_H, F.ws + WS_WINT, MROWS, PW + 256, DM, F.G, (int)blockIdx.x);
        __syncthreads(); S.build_tables(F.lds); __syncthreads();
        gx::EpiInProj E{(bf16_t*)(F.ws + WS_P), (float*)(F.ws + WS_GATE), args.in[I_BIN]};
        gx::gemm_run(F.lds, S, E, DM / 64, DM, DM * 2);
    }
    if constexpr (PH == 3) p3_phase(args, F);
    if constexpr (PH == 4) p4_phase(args, F);
    if constexpr (PH == 5) p5_phase(args, F);
    if constexpr (PH == 6) {
#ifndef NO_ATT
        p6_attention(args, F);
#endif
#ifndef NO_MOUT
        p6_mlstm_out(args, F);
#endif
    }
    if constexpr (PH == 7) {
        gx::PlainSched S; S.init(F.ws + WS_Y, F.ws + WS_WOUTT, NLAT, DM, DM, F.G, (int)blockIdx.x);
        __syncthreads(); S.build_tables(F.lds); __syncthreads();
        gx::EpiOutProj E{args.in[I_X], (float*)(F.ws + WS_X1), (const float*)(F.ws + WS_MOD)};
        gx::gemm_run(F.lds, S, E, DM / 64, DM, DM * 2);
    }
    if constexpr (PH == 8) p8_phase(args, F);
    if constexpr (PH == 9) {
        build_etab(F);
        unsigned* ctl9 = (unsigned*)(F.ws + WS_CTL);
        const int n8 = F.G / 8, cpx = (F.G % 8 == 0 && n8 > CPX) ? CPX : 0;
        const int xl = (int)blockIdx.x & 7, jx = (int)blockIdx.x >> 3;
        if (cpx > 0 && jx < cpx) moe_converter(args, F, (jx * 8 + xl) * NWAVES + F.wave, cpx * 8 * NWAVES, F.G);
        else {
            gx::MoeSched<16, true> S;
            if (cpx > 0) S.init(F.ws + WS_H, F.ws + WS_W1T, F.lds, (n8 - cpx) * 8, (jx - cpx) * 8 + xl, (const int*)(F.ws + WS_LIST), ctl9 + CW_FLAG, ctl9 + CW_TMO);
            else {
                for (int g = (int)blockIdx.x * NWAVES + F.wave; g < 32 * 16 * 128; g += F.G * NWAVES) { const int e = g >> 11, it = g & 2047; cvt_item8<false>(args.in[I_W1] + (size_t)e * 2048 * 4096, 4096, F.ws + WS_W1T + (size_t)e * 4096 * 2048, it >> 7, 32 * (it & 127), F.lane); }
                for (int g = (int)blockIdx.x * NWAVES + F.wave; g < 32 * 16 * 64; g += F.G * NWAVES) { const int e = g >> 10, it = g & 1023; cvt_item8<false>(args.in[I_W2] + (size_t)e * 2048 * 2048, 2048, F.ws + WS_W2T + (size_t)e * 2048 * 2048, it >> 6, 32 * (it & 63), F.lane); }
                S.init(F.ws + WS_H, F.ws + WS_W1T, F.lds, F.G, (int)blockIdx.x, (const int*)(F.ws + WS_LIST)); }
            S.build_tables(F.lds); __syncthreads();
            gx::EpiMoe1 E{F.ws + WS_ACT, args.in[I_B1], 1.0f / 64.0f};
            gx::gemm_run<gx::EpiMoe1, gx::MoeSched<16, true>, true>(F.lds, S, E, DM / 128, DM / 2, DM);
        }
    }
    if constexpr (PH == 10) {
        build_etab(F);
        gx::MoeSched<8, false> S; S.init(F.ws + WS_ACT, F.ws + WS_W2T, F.lds, F.G, (int)blockIdx.x, nullptr);
        S.build_tables(F.lds); __syncthreads();
        gx::EpiBf16Bias E{(bf16_t*)(F.ws + WS_YB), DM, args.in[I_B2], DM, 1.0f / 64.0f};
        gx::gemm_run<gx::EpiBf16Bias, gx::MoeSched<8, false>, true>(F.lds, S, E, DFF / 128, DFF / 2, DFF);
    }
    if constexpr (PH == 11) p11_phase(args, F);
}
__global__ void __launch_bounds__(NTHR, 2) mk_fwd(Args args) {
    extern __shared__ __attribute__((aligned(16))) unsigned char lds[];
    Frame F;
    F.lds = (LAS unsigned char*)lds; F.ldsg = (char*)lds;
    F.tid = threadIdx.x; F.lane = F.tid & 63; F.wave = __builtin_amdgcn_readfirstlane(F.tid >> 6);
    F.G = gridDim.x; { const int bx = blockIdx.x; F.vcu = (F.G % 8 == 0) ? (bx % 8) * (F.G / 8) + bx / 8 : bx; }
    F.ws = args.ws;
    volatile LAS unsigned* MISC = (volatile LAS unsigned*)(F.lds + MISC_OFF);
    if (F.tid < 64) MISC[F.tid] = 0u;
    __syncthreads();
    unsigned* ctl = (unsigned*)(F.ws + WS_CTL);
    XcdBarrier bar; bar.bar = ctl + CW_BAR; bar.x = 0; bar.st = nullptr;
    const int lo = args.ph_lo, hi = args.ph_hi;
    if (hi - lo > 1) bar = xcd_barrier_post(ctl + CW_BAR, MISC + 8);
#ifndef ONLY_PHASE
#define ONLY_PHASE -1
#endif
#define IN(k) ((ONLY_PHASE < 0 || ONLY_PHASE == (k)) && lo <= (k) && (k) < hi)
#define DO_PHASE(k) do { if (IN(k)) { run_phase<k>(args, F); if (DUP_PHASE == (k)) { xcd_barrier(bar); run_phase<k>(args, F); } } \
                         if (IN(k) && IN((k) + 1)) xcd_barrier(bar); } while (0)
    DO_PHASE(0); DO_PHASE(1); DO_PHASE(2); DO_PHASE(3); DO_PHASE(4); DO_PHASE(5);
    DO_PHASE(6); DO_PHASE(7); DO_PHASE(8); DO_PHASE(9); DO_PHASE(10); DO_PHASE(11);
#undef IN
#undef DO_PHASE
}

extern "C" void kernel_launch(void* const* d_in, const int* in_sizes, int n_in, void* d_out, int out_size, void* d_ws, size_t ws_size, hipStream_t stream) {
    static int grid = 0;
    if (grid == 0) {
        if (n_in != 21 || out_size != NLAT * DM || ws_size < WS_END) { fprintf(stderr, "kernel_launch: unexpected shapes (n_in %d out %d ws %zu)\n", n_in, out_size, ws_size); grid = -1; return; }
        int dev = 0, cus = 0, per_cu = 0;
        if (hipGetDevice(&dev) != hipSuccess || hipDeviceGetAttribute(&cus, hipDeviceAttributeMultiprocessorCount, dev) != hipSuccess) { grid = -1; return; }
        if (hipFuncSetAttribute((const void*)mk_fwd, hipFuncAttributeMaxDynamicSharedMemorySize, LDS_BYTES) != hipSuccess) { fprintf(stderr, "kernel_launch: hipFuncSetAttribute failed\n"); grid = -1; return; }
        if (hipOccupancyMaxActiveBlocksPerMultiprocessor(&per_cu, (const void*)mk_fwd, NTHR, LDS_BYTES) != hipSuccess || per_cu < 1) { fprintf(stderr, "kernel_launch: occupancy query says %d blocks per CU\n", per_cu); (void)hipGetLastError(); grid = -1; return; }
        grid = cus;
    }
    if (grid < 0) return;
    (void)hipMemsetAsync((char*)d_ws + WS_CTL, 0, CTL_ZERO_BYTES, stream);
    Args a{};
    for (int i = 0; i < 21; ++i) a.in[i] = (const float*)d_in[i];
    a.out = (float*)d_out; a.ws = (unsigned char*)d_ws;
#if MK_ONE_LAUNCH
    a.ph_lo = 0; a.ph_hi = NPHASE;
    hipLaunchKernelGGL(mk_fwd, dim3(grid), dim3(NTHR), LDS_BYTES, stream, a);
#else
    for (int p = 0; p < NPHASE; ++p) { a.ph_lo = p; a.ph_hi = p + 1; hipLaunchKernelGGL(mk_fwd, dim3(grid), dim3(NTHR), LDS_BYTES, stream, a); }
#endif
    const hipError_t le = hipPeekAtLastError();
    if (le != hipSuccess) fprintf(stderr, "kernel_launch: launch failed: %s\n", hipGetErrorName(le));
}
```

```cpp
#include <hip/hip_runtime.h>
#include <cstdio>
#include <cstdint>

#ifndef MK_ONE_LAUNCH
#define MK_ONE_LAUNCH 1
#endif
#ifndef INPROJ_FP8
#define INPROJ_FP8 0
#endif
#ifndef YB_FP8
#define YB_FP8 1
#endif
#ifndef ATTN_PROJ8
#define ATTN_PROJ8 1
#endif
#ifndef ATT_QK8
#define ATT_QK8 1
#endif
#ifndef PROJ_FP8
#define PROJ_FP8 0
#endif

#define LAS __attribute__((address_space(3)))
#define GAS __attribute__((address_space(1)))
typedef unsigned short bf16_t;
typedef short bf16x8 __attribute__((ext_vector_type(8)));
typedef short s16x4 __attribute__((ext_vector_type(4)));
typedef float f32x2 __attribute__((ext_vector_type(2)));
typedef float f32x4 __attribute__((ext_vector_type(4)));
typedef float f32x16 __attribute__((ext_vector_type(16)));
typedef unsigned u32x2 __attribute__((ext_vector_type(2)));
typedef unsigned u32x4 __attribute__((ext_vector_type(4)));
typedef GAS unsigned gu32;

constexpr int DM = 2048, NB = 2, SEQ = 4096, CTXL = 256, ROWS_B = SEQ + CTXL  , MROWS = NB * ROWS_B  , NLAT = NB * SEQ  ;
constexpr int GRID_W = 64;
constexpr float EPS = 1e-6f;
constexpr int NH = 8, KVH = 2, HD = 128;
constexpr int MH = 4, MDK = 128, MDV = 256, MCH = 128;
constexpr int IN_COLS = 4624, PW = 4608;
constexpr int C_Q = 0, C_K = 1024, C_V = 1280, C_MQ = 1536, C_MK = 2048, C_MV = 2560, C_MO = 3584, C_G = 4608;
constexpr int NEXP = 32, TOPK = 4, DFF = 2048;
constexpr int NTB = ROWS_B / MCH;
constexpr int NCHAIN = NB * 2 * MH;
constexpr int MAXTILES = 160;

constexpr size_t MiB = 1u << 20;
constexpr size_t WS_CTL = 0, CTL_ZERO_BYTES = 1 * MiB;
constexpr size_t WS_MOD = 1 * MiB;
constexpr size_t WS_WRS = 2 * MiB;
constexpr size_t WS_GATE = 3 * MiB;
constexpr size_t WS_GA = 4 * MiB;
constexpr size_t WS_GM = WS_GA + 512 * 1024;
constexpr size_t WS_GB = WS_GM + 512 * 1024;
constexpr size_t WS_GC = WS_GB + 512 * 1024;
constexpr size_t WS_TOKE = 6 * MiB;
constexpr size_t WS_TOKP = WS_TOKE + 128 * 1024;
constexpr size_t WS_TOKW = WS_TOKP + 128 * 1024;
constexpr size_t WS_LIST = 7 * MiB;
constexpr size_t WS_NL = 8 * MiB;
constexpr size_t WS_NST = 9 * MiB;
constexpr size_t WS_WINT = 16 * MiB;
constexpr size_t WS_WOUTT = 36 * MiB;
constexpr size_t WS_H = 48 * MiB;
constexpr size_t WS_P = 96 * MiB;
constexpr size_t WS_Y = 184 * MiB;
constexpr size_t WS_X1 = 224 * MiB;
constexpr size_t WS_LST = 288 * MiB;
constexpr size_t WS_CST = 368 * MiB;
constexpr size_t WS_ACT = 416 * MiB;
constexpr size_t WS_YB = 576 * MiB;
constexpr size_t WS_W1T = 768 * MiB;
constexpr size_t WS_W2T = 1280 * MiB;
constexpr size_t WS_Q8 = 1536 * MiB;
constexpr size_t WS_K8 = 1548 * MiB;
constexpr size_t WS_H8 = 1552 * MiB;
constexpr size_t WS_WIN8 = 1572 * MiB;
constexpr size_t WS_END = 1576 * MiB;
constexpr int CW_TMO = 0;
constexpr int CW_BAR = 4096;
constexpr int CW_CNT = 8192;
constexpr int CW_FLAG = 16384;
constexpr int CPX = 14;
constexpr int W2_TAIL_Q = 96;
constexpr int W2_P5_Q = 8;

constexpr int RING_BYTES = 131072;
constexpr int TAB_OFF = 131072;
constexpr int NSLOT = 32;
constexpr int ETAB_OFF = TAB_OFF + 16384;
constexpr int MISC_OFF = ETAB_OFF + 1024;
constexpr int LDS_BYTES = MISC_OFF + 256;

__device__ __forceinline__ unsigned cvt_pk_bf16(float lo, float hi) { unsigned r; asm volatile("v_cvt_pk_bf16_f32 %0, %1, %2" : "=v"(r) : "v"(lo), "v"(hi)); return r; }
__device__ __forceinline__ float bf2f(unsigned short b) { return __uint_as_float(((unsigned)b) << 16); }
__device__ __forceinline__ float bflo(unsigned w) { return __uint_as_float(w << 16); }
__device__ __forceinline__ float bfhi(unsigned w) { return __uint_as_float(w & 0xffff0000u); }
__device__ __forceinline__ float wave_sum(float v) {
#pragma unroll
    for (int o = 1; o < 64; o <<= 1) v += __shfl_xor(v, o);
    return v;
}
#define LDS_WAIT() asm volatile("s_waitcnt lgkmcnt(0)" ::: "memory")
#define VM_WAIT() asm volatile("s_waitcnt vmcnt(0)" ::: "memory")

#define XB_TMO      128
#define XB_XCNT(j)  (256  + 64 * (j))
#define XB_XSUB(j)  (1280 + 64 * (j))
#define XB_XGEN(j)  (2304 + 64 * (j))
#define XB_TOP      3328
#define XB_TOPGEN   3392
#define XCD_BAR_WORDS 3456
#define XB_SPIN_CAP (1u << 22)
__device__ __forceinline__ unsigned xb_ld(unsigned* p)              { return __hip_atomic_load(p, __ATOMIC_RELAXED, __HIP_MEMORY_SCOPE_AGENT); }
__device__ __forceinline__ unsigned xb_add(unsigned* p, unsigned v) { return __hip_atomic_fetch_add(p, v, __ATOMIC_RELAXED, __HIP_MEMORY_SCOPE_AGENT); }
__device__ __forceinline__ unsigned xb_xcc_id() { return (unsigned)__builtin_amdgcn_s_getreg((3 << 11) | 20) & 0xFu; }
#define XB_SPIN(cond, bar) do { unsigned _sp = 0; while (cond) { __builtin_amdgcn_s_sleep(1); \
    if ((++_sp & 255u) == 0u) { if (xb_ld(&(bar)[XB_TMO])) break; if (_sp > XB_SPIN_CAP) { atomicAdd(&(bar)[XB_TMO], 1u); break; } } } } while (0)
struct XcdBarrier { unsigned* bar; unsigned x; volatile LAS unsigned* st; };
__device__ __forceinline__ XcdBarrier xcd_barrier_post(unsigned* bar, volatile LAS unsigned* st) {
    XcdBarrier b; b.bar = bar; b.x = xb_xcc_id(); b.st = st;
    if (threadIdx.x == 0) (void)xb_add(&bar[XB_XCNT(b.x)], 1u);
    return b;
}
__device__ __forceinline__ void xcd_barrier_complete(unsigned* bar, unsigned x, unsigned& nloc, unsigned& nx) {
    const unsigned G = gridDim.x * gridDim.y * gridDim.z;
    unsigned sum, cnt, mine, sp = 0u;
    for (;;) {
        sum = 0u; cnt = 0u; mine = 0u;
#pragma unroll
        for (unsigned j = 0; j < 16; ++j) { const unsigned c = xb_ld(&bar[XB_XCNT(j)]); sum += c; cnt += (c > 0u) ? 1u : 0u; mine = (j == x) ? c : mine; }
        if (sum == G) break;
        __builtin_amdgcn_s_sleep(1);
        if ((++sp & 255u) == 0u) { if (xb_ld(&bar[XB_TMO])) break; if (sp > XB_SPIN_CAP) { atomicAdd(&bar[XB_TMO], 1u); break; } }
    }
    nloc = mine > 0u ? mine : 1u; nx = cnt > 0u ? cnt : 1u;
}
__device__ __forceinline__ void xcd_barrier(const XcdBarrier& b) {
    asm volatile("s_waitcnt vmcnt(0)" ::: "memory");
    __syncthreads();
    if (threadIdx.x == 0) {
        unsigned* bar = b.bar;
        __builtin_amdgcn_s_waitcnt(0);
        unsigned nloc = b.st[0], nx = b.st[1];
        if (nloc == 0u) { xcd_barrier_complete(bar, b.x, nloc, nx); b.st[0] = nloc; b.st[1] = nx; }
        const unsigned old = xb_add(&bar[XB_XSUB(b.x)], 1u);
        const unsigned gen = old / nloc;
        if (old + 1u == (gen + 1u) * nloc) {
            __builtin_amdgcn_fence(__ATOMIC_RELEASE, "agent");
            asm volatile("s_waitcnt vmcnt(0)" ::: "memory");
            const unsigned og = xb_add(&bar[XB_TOP], 1u);
            const unsigned tg = og / nx;
            if (og + 1u == (tg + 1u) * nx) xb_add(&bar[XB_TOPGEN], 1u);
            else XB_SPIN(xb_ld(&bar[XB_TOPGEN]) == tg, bar);
            __builtin_amdgcn_fence(__ATOMIC_ACQUIRE, "agent");
            xb_add(&bar[XB_XGEN(b.x)], 1u);
            asm volatile("s_waitcnt vmcnt(0)" ::: "memory");
        } else {
            XB_SPIN(xb_ld(&bar[XB_XGEN(b.x)]) == gen, bar);
            __builtin_amdgcn_fence(__ATOMIC_ACQUIRE, "agent");
            asm volatile("s_waitcnt vmcnt(0)" ::: "memory");
        }
    }
    __syncthreads();
}

namespace gx {
constexpr int BM = 256, BK = 64, HALF = 128, HTB = HALF * BK * 2, STAGE_BYTES = 8 * HTB, NXCD = 8;
__host__ __device__ __forceinline__ int lds_byte(int r, int c) { const int st = (r >> 4) * 2 + (c >> 5), rr = r & 15, cc = c & 31, ob = rr * 64 + cc * 2; return st * 1024 + (ob ^ (((ob >> 9) & 1) << 5)); }
__host__ __device__ __forceinline__ void stage_rc(int b, int& R, int& C) { const int st = b / 1024, sb = b % 1024, swz = sb ^ (((sb >> 9) & 1) << 5); R = (st >> 1) * 16 + swz / 64; C = (st & 1) * 32 + (swz % 64) / 2; }
__host__ __device__ __forceinline__ int perm32(int rho) { const int n = rho >> 4, i = rho & 15; return 8 * (i >> 2) + 4 * n + (i & 3); }

struct Unit { const char* A; const char* B0; const char* B1; int slot, pm, pn, e; };

typedef int i32x8 __attribute__((ext_vector_type(8)));
__device__ __forceinline__ i32x8 cat8(bf16x8 lo, bf16x8 hi) { typedef int i32x4 __attribute__((ext_vector_type(4))); const i32x4 a = __builtin_bit_cast(i32x4, lo), b = __builtin_bit_cast(i32x4, hi); return (i32x8){a.x, a.y, a.z, a.w, b.x, b.y, b.z, b.w}; }
template <class Epi, class Sched, bool FP8 = false>
__device__ __forceinline__ void gemm_run(LAS unsigned char* lds, const Sched& S, const Epi& E, const int nt, const int ldb, const unsigned apitch  ) {
    const int tid = threadIdx.x, wid = __builtin_amdgcn_readfirstlane(tid >> 6), lane = tid & 63, wr = wid >> 2, wc = wid & 3, fr = lane & 15, fq = lane >> 4;
    unsigned voffB[2], colA[2]; int rowA[2];
#pragma unroll
    for (int i = 0; i < 2; ++i) { int R, C; stage_rc(tid * 16 + i * 8192, R, C); const int Rb = Epi::PERM ? ((R & ~31) + perm32(R & 31)) : R;
        voffB[i] = (unsigned)(Rb * ldb + C) * 2u; rowA[i] = R; colA[i] = (unsigned)C * 2u; }
    const LAS unsigned short* tab = (const LAS unsigned short*)(lds + TAB_OFF);
    unsigned vA0[2], vA1[2];
#define GX_LOADTAB(slot) do { _Pragma("unroll") for (int _i = 0; _i < 2; ++_i) { vA0[_i] = (unsigned)tab[(slot) * 256 + rowA[_i]] * apitch + colA[_i]; vA1[_i] = (unsigned)tab[(slot) * 256 + 128 + rowA[_i]] * apitch + colA[_i]; } } while (0)
    const size_t kstep = (size_t)(BK * 2);
    const unsigned ldsw = (unsigned)wid * 1024u;
    const int aoff = lds_byte(wr * 64 + fr, fq * 8), boff = lds_byte(wc * 32 + fr, fq * 8);
#define GX_SA(b, h) (((b) * 2 + (h)) * HTB)
#define GX_SB(b, h) ((4 + (b) * 2 + (h)) * HTB)
#define GX_STAGE(bufoff, gbase, voff) do { _Pragma("unroll") for (int _i = 0; _i < 2; ++_i) \
        __builtin_amdgcn_global_load_lds((const unsigned*)((const char*)(gbase) + (voff)[_i]), (LAS unsigned*)(lds + (bufoff) + ldsw + _i * 8192), 16, 0, 0); } while (0)
#define GX_LDA(dst, b, h) do { _Pragma("unroll") for (int m = 0; m < 4; ++m) _Pragma("unroll") for (int k = 0; k < 2; ++k) dst[m][k] = *(const LAS bf16x8*)(lds + GX_SA(b, h) + aoff + m * 2048 + k * 1024); } while (0)
#define GX_LDB(dst, b, h) do { _Pragma("unroll") for (int n = 0; n < 2; ++n) _Pragma("unroll") for (int k = 0; k < 2; ++k) dst[n][k] = *(const LAS bf16x8*)(lds + GX_SB(b, h) + boff + n * 2048 + k * 1024); } while (0)
#define GX_MMA(ai, bj, At, Bt) do { __builtin_amdgcn_s_setprio(1); _Pragma("unroll") for (int m = 0; m < 4; ++m) _Pragma("unroll") for (int n = 0; n < 2; ++n) { \
        if constexpr (FP8) acc[ai][bj][m][n] = __builtin_amdgcn_mfma_scale_f32_16x16x128_f8f6f4(cat8(Bt[n][0], Bt[n][1]), cat8(At[m][0], At[m][1]), acc[ai][bj][m][n], 0, 0, 0, 0x7f7f7f7f, 0, 0x7f7f7f7f); \
        else { _Pragma("unroll") for (int k = 0; k < 2; ++k) acc[ai][bj][m][n] = __builtin_amdgcn_mfma_f32_16x16x32_bf16(Bt[n][k], At[m][k], acc[ai][bj][m][n], 0, 0, 0); } } \
        __builtin_amdgcn_s_setprio(0); } while (0)
#define GX_WAIT_V(n) asm volatile("s_waitcnt vmcnt(" #n ")" ::: "memory")
#define GX_WAIT_L(n) asm volatile("s_waitcnt lgkmcnt(" #n ")" ::: "memory")
#define GX_BAR __builtin_amdgcn_s_barrier()
#define GX_SCHED __builtin_amdgcn_sched_barrier(0)
    Unit cur, nxt; int ui = 0;
    if (!S.next(0, cur)) return;
    f32x4 acc[2][2][4][2];
#pragma unroll
    for (int a = 0; a < 2; ++a)
#pragma unroll
        for (int b = 0; b < 2; ++b)
#pragma unroll
            for (int m = 0; m < 4; ++m)
#pragma unroll
                for (int n = 0; n < 2; ++n) acc[a][b][m][n] = (f32x4){0.f, 0.f, 0.f, 0.f};
    bf16x8 At[4][2], B0[2][2], B1[2][2];
    const char* cA = cur.A; const char* cB0 = cur.B0; const char* cB1 = cur.B1;
    S.a_ready(cur);
    GX_LOADTAB(cur.slot);
    GX_STAGE(GX_SB(0, 0), cB0, voffB); GX_STAGE(GX_SB(0, 1), cB1, voffB); GX_STAGE(GX_SA(0, 0), cA, vA0); GX_STAGE(GX_SA(0, 1), cA, vA1);
    if (wr == 1) GX_BAR;
    GX_WAIT_V(2); GX_BAR;
    GX_STAGE(GX_SB(1, 0), cB0 + kstep, voffB); GX_STAGE(GX_SA(1, 0), cA + kstep, vA0); GX_STAGE(GX_SB(1, 1), cB1 + kstep, voffB);
    GX_WAIT_V(6); GX_BAR;
    for (;;) {
        const bool has_next = S.next(ui + 1, nxt);
        const char* nA = has_next ? nxt.A : cA; const char* nB0 = has_next ? nxt.B0 : cB0; const char* nB1 = has_next ? nxt.B1 : cB1;
        for (int t = 0; t < nt; t += 2) {
            const bool last = (t == nt - 2);
            const char* a1 = cA + (size_t)(t + 1) * kstep;
            const char* a2 = last ? nA : cA + (size_t)(t + 2) * kstep;
            const char* b20 = last ? nB0 : cB0 + (size_t)(t + 2) * kstep; const char* b21 = last ? nB1 : cB1 + (size_t)(t + 2) * kstep;
            const char* a3 = a2 + kstep; const char* b30 = b20 + kstep; const char* b31 = b21 + kstep;
            if (last && has_next) S.a_ready(nxt);
            GX_LDB(B0, 0, 0); GX_LDB(B1, 0, 1); GX_SCHED; GX_LDA(At, 0, 0); GX_STAGE(GX_SA(1, 1), a1, vA1);
            if (last && has_next) GX_LOADTAB(nxt.slot);
            GX_WAIT_V(8); GX_WAIT_L(0); GX_BAR; GX_MMA(0, 0, At, B0); GX_MMA(0, 1, At, B1); GX_BAR; GX_SCHED;
            GX_LDA(At, 0, 1); GX_STAGE(GX_SB(0, 0), b20, voffB); GX_STAGE(GX_SB(0, 1), b21, voffB); GX_STAGE(GX_SA(0, 0), a2, vA0);
            GX_WAIT_V(8); GX_WAIT_L(0); GX_BAR; GX_MMA(1, 0, At, B0); GX_MMA(1, 1, At, B1); GX_BAR; GX_SCHED;
            GX_LDB(B0, 1, 0); GX_LDB(B1, 1, 1); GX_SCHED; GX_LDA(At, 1, 0); GX_STAGE(GX_SA(0, 1), a2, vA1);
            GX_WAIT_V(8); GX_WAIT_L(0); GX_BAR; GX_MMA(0, 0, At, B0); GX_MMA(0, 1, At, B1); GX_BAR; GX_SCHED;
            GX_LDA(At, 1, 1); GX_STAGE(GX_SB(1, 0), b30, voffB); GX_STAGE(GX_SB(1, 1), b31, voffB); GX_STAGE(GX_SA(1, 0), a3, vA0);
            GX_WAIT_V(8); GX_WAIT_L(0); GX_BAR; GX_MMA(1, 0, At, B0); GX_MMA(1, 1, At, B1); GX_BAR; GX_SCHED;
        }
        if (wr == 0) GX_BAR;
        E(acc, cur, wr, wc, fr, fq);
        if (!has_next) break;
#pragma unroll
        for (int a = 0; a < 2; ++a)
#pragma unroll
            for (int b = 0; b < 2; ++b)
#pragma unroll
                for (int m = 0; m < 4; ++m)
#pragma unroll
                    for (int n = 0; n < 2; ++n) acc[a][b][m][n] = (f32x4){0.f, 0.f, 0.f, 0.f};
        cur = nxt; cA = nA; cB0 = nB0; cB1 = nB1; ++ui;
        if (wr == 1) GX_BAR;
    }
    GX_WAIT_V(0);
    GX_BAR;
#undef GX_LOADTAB
#undef GX_SA
#undef GX_SB
#undef GX_STAGE
#undef GX_LDA
#undef GX_LDB
#undef GX_MMA
#undef GX_WAIT_V
#undef GX_WAIT_L
#undef GX_BAR
#undef GX_SCHED
}

struct EpiBf16Bias {
    static constexpr bool PERM = true;
    bf16_t* O; int ldc; const float* bias; int bias_estride; float ascale;
    __device__ __forceinline__ void operator()(const f32x4 (&acc)[2][2][4][2], const Unit& u, int wr, int wc, int fr, int fq) const {
        const int row0 = u.pm * BM + wr * 64 + fr, col0 = u.pn * BM + wc * 32 + 8 * fq;
        const float* bp = bias + (size_t)u.e * bias_estride + col0;
        f32x4 bv[2][2];
#pragma unroll
        for (int bj = 0; bj < 2; ++bj)
#pragma unroll
            for (int n = 0; n < 2; ++n) bv[bj][n] = *(const f32x4*)(bp + bj * HALF + 4 * n);
#pragma unroll
        for (int ai = 0; ai < 2; ++ai)
#pragma unroll
            for (int m = 0; m < 4; ++m) { bf16_t* rowp = O + (size_t)(row0 + ai * HALF + m * 16) * ldc + col0;
#pragma unroll
                for (int bj = 0; bj < 2; ++bj) { const f32x4 v0 = acc[ai][bj][m][0] * ascale + bv[bj][0], v1 = acc[ai][bj][m][1] * ascale + bv[bj][1];
                    u32x4 w; w.x = cvt_pk_bf16(v0[0], v0[1]); w.y = cvt_pk_bf16(v0[2], v0[3]); w.z = cvt_pk_bf16(v1[0], v1[1]); w.w = cvt_pk_bf16(v1[2], v1[3]);
                    *(u32x4*)(rowp + bj * HALF) = w; } }
    }
};
struct EpiF8Bias {
    static constexpr bool PERM = true;
    unsigned char* O; int ldc; const float* bias; int bias_estride; float ascale;
    __device__ __forceinline__ void operator()(const f32x4 (&acc)[2][2][4][2], const Unit& u, int wr, int wc, int fr, int fq) const {
        const int row0 = u.pm * BM + wr * 64 + fr, col0 = u.pn * BM + wc * 32 + 8 * fq;
        const float* bp = bias + (size_t)u.e * bias_estride + col0;
        f32x4 bv[2][2];
#pragma unroll
        for (int bj = 0; bj < 2; ++bj)
#pragma unroll
            for (int n = 0; n < 2; ++n) bv[bj][n] = *(const f32x4*)(bp + bj * HALF + 4 * n);
#pragma unroll
        for (int ai = 0; ai < 2; ++ai)
#pragma unroll
            for (int m = 0; m < 4; ++m) { unsigned char* rowp = O + (size_t)(row0 + ai * HALF + m * 16) * ldc + col0;
#pragma unroll
                for (int bj = 0; bj < 2; ++bj) { const f32x4 v0 = acc[ai][bj][m][0] * ascale + bv[bj][0], v1 = acc[ai][bj][m][1] * ascale + bv[bj][1];
                    int w0 = 0, w1 = 0; w0 = __builtin_amdgcn_cvt_pk_fp8_f32(v0[0], v0[1], w0, false); w0 = __builtin_amdgcn_cvt_pk_fp8_f32(v0[2], v0[3], w0, true);
                    w1 = __builtin_amdgcn_cvt_pk_fp8_f32(v1[0], v1[1], w1, false); w1 = __builtin_amdgcn_cvt_pk_fp8_f32(v1[2], v1[3], w1, true);
                    *(u32x2*)(rowp + bj * HALF) = (u32x2){(unsigned)w0, (unsigned)w1}; } }
    }
};
struct EpiInProj {
    static constexpr bool PERM = true;
    bf16_t* O; float* gate; const float* bias; float ascale;
    __device__ __forceinline__ void operator()(const f32x4 (&acc)[2][2][4][2], const Unit& u, int wr, int wc, int fr, int fq) const {
        if (u.pn < 18) { EpiBf16Bias E{O, PW, bias, 0, ascale}; E(acc, u, wr, wc, fr, fq); return; }
        if (wc == 0 && fq < 2) { const int row0 = u.pm * BM + wr * 64 + fr; const float* bp = bias + C_G + 8 * fq;
            const f32x4 b0 = *(const f32x4*)bp, b1 = *(const f32x4*)(bp + 4);
#pragma unroll
            for (int ai = 0; ai < 2; ++ai)
#pragma unroll
                for (int m = 0; m < 4; ++m) { float* gp = gate + (size_t)(row0 + ai * HALF + m * 16) * 16 + 8 * fq;
                    *(f32x4*)gp = acc[ai][0][m][0] * ascale + b0; *(f32x4*)(gp + 4) = acc[ai][0][m][1] * ascale + b1; } }
    }
};
struct EpiOutProj {
    static constexpr bool PERM = false;
    const float* x; float* x1; const float* mod; float ascale;
    __device__ __forceinline__ void operator()(const f32x4 (&acc)[2][2][4][2], const Unit& u, int wr, int wc, int fr, int fq) const {
        const int row0 = u.pm * BM + wr * 64 + fr, col0 = u.pn * BM + wc * 32 + 4 * fq;
        const int b = u.pm >> 4;
        const float* gp = mod + (size_t)b * 12288 + 4096 + col0;
        f32x4 gv[2][2];
#pragma unroll
        for (int bj = 0; bj < 2; ++bj)
#pragma unroll
            for (int n = 0; n < 2; ++n) gv[bj][n] = *(const f32x4*)(gp + bj * HALF + n * 16) * ascale;
#pragma unroll
        for (int ai = 0; ai < 2; ++ai) { f32x4 xv[4][2][2];
#pragma unroll
            for (int m = 0; m < 4; ++m) { const size_t off = (size_t)(row0 + ai * HALF + m * 16) * DM + col0;
#pragma unroll
                for (int bj = 0; bj < 2; ++bj)
#pragma unroll
                    for (int n = 0; n < 2; ++n) xv[m][bj][n] = *(const f32x4*)(x + off + bj * HALF + n * 16); }
            __builtin_amdgcn_sched_barrier(0);
#pragma unroll
            for (int m = 0; m < 4; ++m) { const size_t off = (size_t)(row0 + ai * HALF + m * 16) * DM + col0;
#pragma unroll
                for (int bj = 0; bj < 2; ++bj)
#pragma unroll
                    for (int n = 0; n < 2; ++n) *(f32x4*)(x1 + off + bj * HALF + n * 16) = xv[m][bj][n] + gv[bj][n] * acc[ai][bj][m][n]; } }
    }
};
struct EpiMoe1 {
    static constexpr bool PERM = true;
    unsigned char* act; const float* b1; float ascale;
    __device__ __forceinline__ void operator()(const f32x4 (&acc)[2][2][4][2], const Unit& u, int wr, int wc, int fr, int fq) const {
        const int row0 = u.pm * BM + wr * 64 + fr, c0 = u.pn * HALF + wc * 32 + 8 * fq;
        const float* bp = b1 + (size_t)u.e * 4096 + c0;
        f32x4 bg[2], bu[2];
#pragma unroll
        for (int n = 0; n < 2; ++n) { bg[n] = *(const f32x4*)(bp + 4 * n); bu[n] = *(const f32x4*)(bp + 2048 + 4 * n); }
#pragma unroll
        for (int ai = 0; ai < 2; ++ai)
#pragma unroll
            for (int m = 0; m < 4; ++m) { unsigned char* rowp = act + (size_t)(row0 + ai * HALF + m * 16) * DFF + c0;
                float o[8];
#pragma unroll
                for (int n = 0; n < 2; ++n)
#pragma unroll
                    for (int j = 0; j < 4; ++j) { float g = acc[ai][0][m][n][j] * ascale + bg[n][j], up = acc[ai][1][m][n][j] * ascale + bu[n][j];
                        g = fminf(g, 7.0f); up = fminf(fmaxf(up, -7.0f), 7.0f);
                        const float glu = g * __builtin_amdgcn_rcpf(1.0f + __expf(-1.702f * g));
                        o[n * 4 + j] = (up + 1.0f) * glu; }
                int w0 = 0, w1 = 0;
                w0 = __builtin_amdgcn_cvt_pk_fp8_f32(o[0], o[1], w0, false); w0 = __builtin_amdgcn_cvt_pk_fp8_f32(o[2], o[3], w0, true);
                w1 = __builtin_amdgcn_cvt_pk_fp8_f32(o[4], o[5], w1, false); w1 = __builtin_amdgcn_cvt_pk_fp8_f32(o[6], o[7], w1, true);
                *(u32x2*)rowp = (u32x2){(unsigned)w0, (unsigned)w1}; }
    }
};

struct PlainSched {
    const char* A; const char* Bt; int K; int nM, nN, nwg, G, c; int pn_off = 0;
    __device__ __forceinline__ void init(const void* A_, const void* Bt_, int M, int N, int Kbytes, int G_, int c_) { A = (const char*)A_; Bt = (const char*)Bt_; K = Kbytes; nM = M / BM; nN = N / BM; nwg = nM * nN; G = G_; c = c_; }
    __device__ __forceinline__ bool tile(int i, int& pm, int& pn) const {
        const long L = (long)i * G + c; if (L >= nwg || i >= NSLOT) return false;
        int wgid = (int)L; { const int q = nwg / NXCD, r = nwg % NXCD, xcd = wgid % NXCD, off = wgid / NXCD; wgid = (xcd < r ? xcd * (q + 1) : r * (q + 1) + (xcd - r) * q) + off; }
        const int WGM = 8, nig = WGM * nN, gid = wgid / nig, fm = gid * WGM, gsz = (nM - fm) < WGM ? (nM - fm) : WGM;
        pm = fm + ((wgid % nig) % gsz); pn = (wgid % nig) / gsz; return true;
    }
    __device__ __forceinline__ bool next(int i, Unit& u) const {
        int pm, pn; if (!tile(i, pm, pn)) return false;
        u.A = A; u.B0 = Bt + (size_t)pn * BM * K; u.B1 = u.B0 + (size_t)HALF * K; u.slot = i; u.pm = pm; u.pn = pn + pn_off; u.e = 0; return true;
    }
    __device__ __forceinline__ void a_ready(const Unit&) const {}
    __device__ __forceinline__ void build_tables(LAS unsigned char* lds) const {
        LAS unsigned short* tab = (LAS unsigned short*)(lds + TAB_OFF);
        for (int i = 0; i < NSLOT; ++i) { int pm, pn; if (!tile(i, pm, pn)) break;
            if (threadIdx.x < 256) tab[i * 256 + threadIdx.x] = (unsigned short)(pm * BM + threadIdx.x); }
    }
};
template <int NT  , bool GATHER>
struct MoeSched {
    const char* A; const char* W; LAS const int* et; int nunits, G, c; const int* list; unsigned* flags; unsigned* tmo;
    __device__ __forceinline__ void init(const void* A_, const void* W_, LAS unsigned char* lds, int G_, int c_, const int* list_, unsigned* flags_ = nullptr, unsigned* tmo_ = nullptr) {
        A = (const char*)A_; W = (const char*)W_; et = (LAS const int*)(lds + ETAB_OFF); G = G_; c = c_; list = list_; flags = flags_; tmo = tmo_;
        nunits = __builtin_amdgcn_readfirstlane(et[64 + 32]) * NT;
    }
    __device__ __forceinline__ bool map(int i, int& e, int& nt, int& mt) const {
        const long L = (long)i * G + c; if (L >= nunits || i >= NSLOT) return false;
        int wgid = (int)L; { const int q = nunits / NXCD, r = nunits % NXCD, xcd = wgid % NXCD, off = wgid / NXCD; wgid = (xcd < r ? xcd * (q + 1) : r * (q + 1) + (xcd - r) * q) + off; }
        const int lane = threadIdx.x & 63, le = lane & 31;
        const int t0 = et[64 + le] * NT, t1 = et[64 + le + 1] * NT;
        const unsigned long long hit = __ballot(wgid >= t0 && wgid < t1);
        e = __builtin_amdgcn_readfirstlane((int)__builtin_ctzll(hit)) & 31;
        const int ub = __builtin_amdgcn_readfirstlane(et[64 + e]) * NT, tl = __builtin_amdgcn_readfirstlane(et[32 + e]);
        const int local = wgid - ub; nt = local / tl; mt = local - nt * tl; return true;
    }
    __device__ __forceinline__ bool next(int i, Unit& u) const {
        int e, nt, mt; if (!map(i, e, nt, mt)) return false;
        const int tb = __builtin_amdgcn_readfirstlane(et[64 + e]);
        u.A = A; u.slot = i; u.pm = tb + mt; u.pn = nt; u.e = e;
        if (NT == 16) { u.B0 = W + ((size_t)e * 4096 + (size_t)nt * HALF) * DM; u.B1 = u.B0 + (size_t)2048 * DM; }
        else { u.B0 = W + ((size_t)e * 2048 + (size_t)nt * BM) * DFF; u.B1 = u.B0 + (size_t)HALF * DFF; }
        return true;
    }
    __device__ __forceinline__ void a_ready(const Unit& u) const {
        if (flags == nullptr) return;
        if (threadIdx.x < 64) {
            unsigned* w = flags + 64 * (u.e * 16 + u.pn); unsigned spins = 0;
            while ((unsigned)__builtin_amdgcn_readfirstlane(__hip_atomic_load(w, __ATOMIC_RELAXED, __HIP_MEMORY_SCOPE_AGENT)) < 128u) {
                __builtin_amdgcn_s_sleep(2);
                if ((++spins & 255u) == 0u) { if (__builtin_amdgcn_readfirstlane(__hip_atomic_load(tmo, __ATOMIC_RELAXED, __HIP_MEMORY_SCOPE_AGENT)) != 0u) break;
                    if (spins > (1u << 20)) { if (threadIdx.x == 0) __hip_atomic_store(tmo, 1u, __ATOMIC_RELAXED, __HIP_MEMORY_SCOPE_AGENT); break; } } }
            __builtin_amdgcn_fence(__ATOMIC_ACQUIRE, "agent");
            asm volatile("s_waitcnt vmcnt(0)" ::: "memory");
        }
        asm volatile("" ::: "memory"); __builtin_amdgcn_s_barrier(); asm volatile("" ::: "memory");
    }
    __device__ __forceinline__ void build_tables(LAS unsigned char* lds) const {
        LAS unsigned short* tab = (LAS unsigned short*)(lds + TAB_OFF);
        for (int i = 0; i < NSLOT; ++i) { int e, nt, mt; if (!map(i, e, nt, mt)) break;
            if (threadIdx.x < 256) { int row;
                if (GATHER) { const int pos = mt * BM + (int)threadIdx.x; const int cnt = et[e]; row = pos < cnt ? list[e * 8192 + pos] : 0; }
                else row = (et[64 + e] + mt) * BM + (int)threadIdx.x;
                tab[i * 256 + threadIdx.x] = (unsigned short)row; } }
    }
};
}

namespace att {
constexpr int D = 128, NW = 8, QBLK = 32, KVBLK = 64;
constexpr float SCALE = 0.088388347648318440f;
constexpr float THR = 8.f;
constexpr int SHM_V = KVBLK * D * 2, SHM_K = KVBLK * D * 2, SHM_ATTN = 2 * SHM_V + 2 * SHM_K + NW * 64 * 4;
#define KSWZ(row, colB) ((row) * 256 + ((colB) ^ (((row) & 7) << 4)))
#define SBAR() __builtin_amdgcn_sched_barrier(0)
__device__ __forceinline__ int crow(int r, int hi) { return (r & 3) + 8 * (r >> 2) + 4 * hi; }
__device__ __forceinline__ void partialSM(f32x16& p0, f32x16& p1, float& m_reg, float& mn, float& alpha) {
  constexpr float C = SCALE * 1.4426950408889634f;
  float pmax = p0[0];
#pragma unroll
  for (int r = 1; r < 16; ++r) pmax = fmaxf(pmax, p0[r]);
#pragma unroll
  for (int r = 0; r < 16; ++r) pmax = fmaxf(pmax, p1[r]);
  { auto rr = __builtin_amdgcn_permlane32_swap(__float_as_uint(pmax), __float_as_uint(pmax), false, false);
    pmax = fmaxf(__uint_as_float(rr[0]), __uint_as_float(rr[1])); }
  if (__builtin_expect(__all(pmax - m_reg <= THR / SCALE), 1)) { mn = m_reg; alpha = 1.f; }
  else { mn = fmaxf(m_reg, pmax); alpha = __builtin_amdgcn_exp2f((m_reg - mn) * C); m_reg = mn; }
  float mnC = -mn * C;
#pragma unroll
  for (int r = 0; r < 16; ++r) p0[r] = fmaf(p0[r], C, mnC);
#pragma unroll
  for (int r = 0; r < 16; ++r) p1[r] = fmaf(p1[r], C, mnC);
#pragma unroll
  for (int r = 0; r < 16; ++r) p0[r] = __builtin_amdgcn_exp2f(p0[r]);
}
#define PK4(P, BASE, OUT) do { unsigned a0 = cvt_pk_bf16(P[BASE + 0], P[BASE + 1]), a1 = cvt_pk_bf16(P[BASE + 2], P[BASE + 3]);   \
    unsigned b0 = cvt_pk_bf16(P[BASE + 4], P[BASE + 5]), b1 = cvt_pk_bf16(P[BASE + 6], P[BASE + 7]);                              \
    auto r0 = __builtin_amdgcn_permlane32_swap(a0, b0, false, false); auto r1 = __builtin_amdgcn_permlane32_swap(a1, b1, false, false); \
    u32x4 w = {r0[0], r1[0], r0[1], r1[1]}; OUT = *reinterpret_cast<bf16x8*>(&w); } while (0)
__device__ __forceinline__ void finishSM(f32x16& p0, f32x16& p1, float alpha, float& l_reg, bf16x8& pa0, bf16x8& pa1, bf16x8& pa2, bf16x8& pa3) {
#pragma unroll
  for (int r = 0; r < 16; ++r) p1[r] = __builtin_amdgcn_exp2f(p1[r]);
  float ps = 0;
#pragma unroll
  for (int r = 0; r < 16; ++r) ps += p0[r];
#pragma unroll
  for (int r = 0; r < 16; ++r) ps += p1[r];
  { auto rr = __builtin_amdgcn_permlane32_swap(__float_as_uint(ps), __float_as_uint(ps), false, false);
    ps = __uint_as_float(rr[0]) + __uint_as_float(rr[1]); }
  l_reg = l_reg * alpha + ps;
  PK4(p0, 0, pa0); PK4(p0, 8, pa1); PK4(p1, 0, pa2); PK4(p1, 8, pa3);
}
__device__ __forceinline__ void qkt(f32x16& p0, f32x16& p1, const char* Ks, const bf16x8* qr, int r32, int hi) {
  p0 = f32x16{}; p1 = f32x16{};
#pragma unroll
  for (int d0 = 0; d0 < 8; ++d0) { int cb = (d0 * 16 + hi * 8) * 2;
    bf16x8 b0 = *reinterpret_cast<const bf16x8*>(Ks + KSWZ(r32, cb));
    bf16x8 b1 = *reinterpret_cast<const bf16x8*>(Ks + KSWZ(32 + r32, cb));
    p0 = __builtin_amdgcn_mfma_f32_32x32x16_bf16(b0, qr[d0], p0, 0, 0, 0);
    p1 = __builtin_amdgcn_mfma_f32_32x32x16_bf16(b1, qr[d0], p1, 0, 0, 0); }
}
__device__ __forceinline__ int v_st(int k, int c) { const int kk = (k & ~0xC) | ((k & 4) << 1) | ((k & 8) >> 1); return ((kk >> 3) * 4 + (c >> 5)) * 512 + ((kk & 7) * 32 + (c & 31)) * 2; }
__device__ __forceinline__ int v_rd_base(int lane) { return ((lane & 3) << 3) | (((lane >> 2) & 3) << 6) | (((lane >> 4) & 1) << 5) | (((lane >> 5) & 1) << 8); }
constexpr int v_rd_off(int d0, int ks, int half) { return d0 * 512 + ks * 4096 + half * 2048; }
template <int OFF> __device__ __forceinline__ s16x4 tr_read(int vb) {
  s16x4 r; asm volatile("ds_read_b64_tr_b16 %0, %1 offset:%2" : "=&v"(r) : "v"(vb), "i"(OFF) : "memory"); return r;
}
#define PKLH(L, H) (bf16x8){L[0], L[1], L[2], L[3], H[0], H[1], H[2], H[3]}
template <int D0> __device__ __forceinline__ void pv_one(f32x16& od, int vb, bf16x8 pa0, bf16x8 pa1, bf16x8 pa2, bf16x8 pa3) {
  const s16x4 l0 = tr_read<v_rd_off(D0, 0, 0)>(vb), h0 = tr_read<v_rd_off(D0, 0, 1)>(vb), l1 = tr_read<v_rd_off(D0, 1, 0)>(vb), h1 = tr_read<v_rd_off(D0, 1, 1)>(vb);
  const s16x4 l2 = tr_read<v_rd_off(D0, 2, 0)>(vb), h2 = tr_read<v_rd_off(D0, 2, 1)>(vb), l3 = tr_read<v_rd_off(D0, 3, 0)>(vb), h3 = tr_read<v_rd_off(D0, 3, 1)>(vb);
  asm volatile("s_waitcnt lgkmcnt(0)" ::: "memory"); SBAR();
  od = __builtin_amdgcn_mfma_f32_32x32x16_bf16(pa0, PKLH(l0, h0), od, 0, 0, 0);
  od = __builtin_amdgcn_mfma_f32_32x32x16_bf16(pa1, PKLH(l1, h1), od, 0, 0, 0);
  od = __builtin_amdgcn_mfma_f32_32x32x16_bf16(pa2, PKLH(l2, h2), od, 0, 0, 0);
  od = __builtin_amdgcn_mfma_f32_32x32x16_bf16(pa3, PKLH(l3, h3), od, 0, 0, 0);
}
__device__ __forceinline__ void pv_d0(f32x16* o, int vb, bf16x8 pa0, bf16x8 pa1, bf16x8 pa2, bf16x8 pa3) {
  pv_one<0>(o[0], vb, pa0, pa1, pa2, pa3); pv_one<1>(o[1], vb, pa0, pa1, pa2, pa3); pv_one<2>(o[2], vb, pa0, pa1, pa2, pa3); pv_one<3>(o[3], vb, pa0, pa1, pa2, pa3);
}
template <int LDQ, int LDK, int LDO, bool OUT8>
__device__ __forceinline__ void attn_dense_body(const bf16_t* __restrict__ Qb, const bf16_t* __restrict__ Kh, const bf16_t* __restrict__ Vh,
                                                void* __restrict__ Ob_, int seq, char* lds) {
  const int tid = threadIdx.x, wid = tid >> 6, lane = tid & 63, r32 = lane & 31, hi = lane >> 5;
  char* V_lds = lds; char* K_lds = lds + 2 * SHM_V;
  float* ws = (float*)(lds + 2 * SHM_V + 2 * SHM_K) + wid * 64; float* li_l = ws; float* al_l = ws + 32;
  float m_reg = -1e30f, l_reg = 0; f32x16 o[4] = {}; bf16x8 qr[8];
  const bf16_t* Qw = Qb + (long)(wid * QBLK + r32) * LDQ + hi * 8;
#pragma unroll
  for (int d0 = 0; d0 < 8; ++d0) qr[d0] = *reinterpret_cast<const bf16x8*>(Qw + d0 * 16);
  const int sr = tid >> 4, sc = (tid & 15) * 8, vst0 = v_st(sr, sc), vst1 = v_st(32 + sr, sc);
  const int vb0 = (int)(uintptr_t)V_lds + v_rd_base(lane);
  struct { bf16x8 vs0, vs1, ks0, ks1; } sr_[2];
#define SLOAD(i, k0) do { sr_[i].vs0 = *reinterpret_cast<const bf16x8*>(&Vh[(long)((k0) + sr) * LDK + sc]); sr_[i].vs1 = *reinterpret_cast<const bf16x8*>(&Vh[(long)((k0) + 32 + sr) * LDK + sc]); \
    sr_[i].ks0 = *reinterpret_cast<const bf16x8*>(&Kh[(long)((k0) + sr) * LDK + sc]); sr_[i].ks1 = *reinterpret_cast<const bf16x8*>(&Kh[(long)((k0) + 32 + sr) * LDK + sc]); } while (0)
#define SWRITE(b, i) do { *(bf16x8*)(V_lds + (b) * SHM_V + vst0) = sr_[i].vs0;          \
    *(bf16x8*)(V_lds + (b) * SHM_V + vst1) = sr_[i].vs1; int kc = sc * 2;               \
    *(bf16x8*)(K_lds + (b) * SHM_K + KSWZ(sr, kc)) = sr_[i].ks0;                       \
    *(bf16x8*)(K_lds + (b) * SHM_K + KSWZ(32 + sr, kc)) = sr_[i].ks1; } while (0)
#define SWAIT() asm volatile("s_waitcnt vmcnt(4)" ::: "memory")
#define RESC(a) do { if (__any((a) < 1.f)) { if (hi == 0) al_l[r32] = (a); asm volatile("s_waitcnt lgkmcnt(0)" ::: "memory"); \
    _Pragma("unroll") for (int d = 0; d < 4; ++d) _Pragma("unroll") for (int r = 0; r < 16; ++r) o[d][r] *= al_l[crow(r, hi)]; } } while (0)
  f32x16 pA0, pA1, pB0, pB1; float mnA, mnB, alA, alB; bf16x8 pa0, pa1, pa2, pa3; const int NT = seq / KVBLK;
  constexpr int SE = 0, SO = 1;
  SLOAD(SE, 0); asm volatile("s_waitcnt vmcnt(0)" ::: "memory"); SWRITE(0, SE); __syncthreads();
  qkt(pA0, pA1, K_lds, qr, r32, hi); partialSM(pA0, pA1, m_reg, mnA, alA);
  SLOAD(SO, KVBLK); if (2 < NT) SLOAD(SE, 2 * KVBLK);
  SWAIT(); SWRITE(1, SO); __syncthreads();
  for (int j = 1; j + 1 < NT; j += 2) {
    SBAR(); qkt(pB0, pB1, K_lds + SHM_K, qr, r32, hi);
    finishSM(pA0, pA1, alA, l_reg, pa0, pa1, pa2, pa3); SBAR();
    SLOAD(SO, (j + 2) * KVBLK); SBAR();
    pv_d0(o, vb0, pa0, pa1, pa2, pa3); partialSM(pB0, pB1, m_reg, mnB, alB);
    __syncthreads(); SWAIT(); SWRITE(0, SE);
    RESC(alB); __syncthreads();
    SBAR(); qkt(pA0, pA1, K_lds, qr, r32, hi);
    finishSM(pB0, pB1, alB, l_reg, pa0, pa1, pa2, pa3); SBAR();
    if (j + 3 < NT) SLOAD(SE, (j + 3) * KVBLK); SBAR();
    pv_d0(o, vb0 + (int)SHM_V, pa0, pa1, pa2, pa3); partialSM(pA0, pA1, m_reg, mnA, alA);
    __syncthreads(); SWAIT(); SWRITE(1, SO);
    RESC(alA); __syncthreads();
  }
  SBAR(); qkt(pB0, pB1, K_lds + SHM_K, qr, r32, hi);
  finishSM(pA0, pA1, alA, l_reg, pa0, pa1, pa2, pa3); SBAR();
  pv_d0(o, vb0, pa0, pa1, pa2, pa3); partialSM(pB0, pB1, m_reg, mnB, alB);
  __syncthreads(); RESC(alB);
  finishSM(pB0, pB1, alB, l_reg, pa0, pa1, pa2, pa3); SBAR();
  pv_d0(o, vb0 + (int)SHM_V, pa0, pa1, pa2, pa3);
  if (hi == 0) li_l[r32] = l_reg; asm volatile("s_waitcnt lgkmcnt(0)" ::: "memory");
  float rli[16];
#pragma unroll
  for (int r = 0; r < 16; ++r) rli[r] = __builtin_amdgcn_rcpf(li_l[crow(r, hi)]);
  if constexpr (OUT8) { unsigned char* Ow = (unsigned char*)Ob_ + (long)(wid * QBLK) * LDO;
#pragma unroll
    for (int r = 0; r < 16; ++r) { int orow = crow(r, hi);
#pragma unroll
      for (int d0 = 0; d0 < 4; ++d0) { const float v = o[d0][r] * rli[r] * 8.0f; Ow[(long)orow * LDO + d0 * 32 + r32] = (unsigned char)(__builtin_amdgcn_cvt_pk_fp8_f32(v, v, 0, false) & 0xff); } }
  } else { bf16_t* Ow = (bf16_t*)Ob_ + (long)(wid * QBLK) * LDO;
#pragma unroll
    for (int r = 0; r < 16; ++r) { int orow = crow(r, hi);
#pragma unroll
      for (int d0 = 0; d0 < 4; ++d0) { const float v = o[d0][r] * rli[r]; Ow[(long)orow * LDO + d0 * 32 + r32] = (bf16_t)(cvt_pk_bf16(v, v) & 0xffffu); } } }
  __syncthreads();
#undef SLOAD
#undef SWRITE
#undef SWAIT
#undef RESC
}

typedef int i32x8a __attribute__((ext_vector_type(8)));
__device__ __forceinline__ int k8_off(int row, int c) { return row * 128 + ((c ^ ((row >> 1) & 7)) << 4); }
__device__ __forceinline__ i32x8a ld32(const char* p0, const char* p1) { const u32x4 a = *reinterpret_cast<const u32x4*>(p0), b = *reinterpret_cast<const u32x4*>(p1); return (i32x8a){(int)a.x, (int)a.y, (int)a.z, (int)a.w, (int)b.x, (int)b.y, (int)b.z, (int)b.w}; }
__device__ __forceinline__ void qkt8(f32x16& p0, f32x16& p1, const char* Ks, const i32x8a* qf, int r32, int hi) {
  p0 = f32x16{}; p1 = f32x16{};
#pragma unroll
  for (int s = 0; s < 2; ++s) { const int c0 = 4 * s + 2 * hi;
    const i32x8a a0 = ld32(Ks + k8_off(r32, c0), Ks + k8_off(r32, c0 + 1)), a1 = ld32(Ks + k8_off(32 + r32, c0), Ks + k8_off(32 + r32, c0 + 1));
    p0 = __builtin_amdgcn_mfma_scale_f32_32x32x64_f8f6f4(a0, qf[s], p0, 0, 0, 0, 0x7f7f7f7f, 0, 0x7f7f7f7f);
    p1 = __builtin_amdgcn_mfma_scale_f32_32x32x64_f8f6f4(a1, qf[s], p1, 0, 0, 0, 0x7f7f7f7f, 0, 0x7f7f7f7f); }
}
template <int LDQ8, int LDK8, int LDV, int LDO>
__device__ __forceinline__ void attn_dense_body_q8(const unsigned char* __restrict__ Qb8, const unsigned char* __restrict__ Kh8, const bf16_t* __restrict__ Vh,
                                                   bf16_t* __restrict__ Ob, int seq, char* lds) {
  const int tid = threadIdx.x, wid = tid >> 6, lane = tid & 63, r32 = lane & 31, hi = lane >> 5;
  char* V_lds = lds; char* K_lds = lds + 2 * SHM_V;
  float* ws = (float*)(lds + 2 * SHM_V + 2 * SHM_K) + wid * 64; float* li_l = ws; float* al_l = ws + 32;
  float m_reg = -1e30f, l_reg = 0; f32x16 o[4] = {}; i32x8a qf[2];
  { const unsigned char* Qw = Qb8 + (long)(wid * QBLK + r32) * LDQ8 + 32 * hi;
#pragma unroll
    for (int s = 0; s < 2; ++s) qf[s] = ld32((const char*)Qw + 64 * s, (const char*)Qw + 64 * s + 16); }
  const int sr = tid >> 4, sc = (tid & 15) * 8, vst0 = v_st(sr, sc), vst1 = v_st(32 + sr, sc);
  const int kr = tid >> 3, kc = tid & 7, kst = k8_off(kr, kc);
  const int vb0 = (int)(uintptr_t)V_lds + v_rd_base(lane);
  struct { bf16x8 vs0, vs1; u32x4 ks; } sr_[2];
#define SLOAD(i, k0) do { sr_[i].vs0 = *reinterpret_cast<const bf16x8*>(&Vh[(long)((k0) + sr) * LDV + sc]); sr_[i].vs1 = *reinterpret_cast<const bf16x8*>(&Vh[(long)((k0) + 32 + sr) * LDV + sc]); \
    sr_[i].ks = *reinterpret_cast<const u32x4*>(&Kh8[(long)((k0) + kr) * LDK8 + 16 * kc]); } while (0)
#define SWRITE(b, i) do { *(bf16x8*)(V_lds + (b) * SHM_V + vst0) = sr_[i].vs0; *(bf16x8*)(V_lds + (b) * SHM_V + vst1) = sr_[i].vs1; \
    *(u32x4*)(K_lds + (b) * SHM_K + kst) = sr_[i].ks; } while (0)
#define SWAIT() asm volatile("s_waitcnt vmcnt(3)" ::: "memory")
#define RESC(a) do { if (__any((a) < 1.f)) { if (hi == 0) al_l[r32] = (a); asm volatile("s_waitcnt lgkmcnt(0)" ::: "memory"); \
    _Pragma("unroll") for (int d = 0; d < 4; ++d) _Pragma("unroll") for (int r = 0; r < 16; ++r) o[d][r] *= al_l[crow(r, hi)]; } } while (0)
  f32x16 pA0, pA1, pB0, pB1; float mnA, mnB, alA, alB; bf16x8 pa0, pa1, pa2, pa3; const int NT = seq / KVBLK;
  constexpr int SE = 0, SO = 1;
  SLOAD(SE, 0); asm volatile("s_waitcnt vmcnt(0)" ::: "memory"); SWRITE(0, SE); __syncthreads();
  qkt8(pA0, pA1, K_lds, qf, r32, hi); partialSM(pA0, pA1, m_reg, mnA, alA);
  SLOAD(SO, KVBLK); if (2 < NT) SLOAD(SE, 2 * KVBLK);
  SWAIT(); SWRITE(1, SO); __syncthreads();
  for (int j = 1; j + 1 < NT; j += 2) {
    SBAR(); qkt8(pB0, pB1, K_lds + SHM_K, qf, r32, hi);
    finishSM(pA0, pA1, alA, l_reg, pa0, pa1, pa2, pa3); SBAR();
    SLOAD(SO, (j + 2) * KVBLK); SBAR();
    pv_d0(o, vb0, pa0, pa1, pa2, pa3); partialSM(pB0, pB1, m_reg, mnB, alB);
    __syncthreads(); SWAIT(); SWRITE(0, SE);
    RESC(alB); __syncthreads();
    SBAR(); qkt8(pA0, pA1, K_lds, qf, r32, hi);
    finishSM(pB0, pB1, alB, l_reg, pa0, pa1, pa2, pa3); SBAR();
    if (j + 3 < NT) SLOAD(SE, (j + 3) * KVBLK); SBAR();
    pv_d0(o, vb0 + (int)SHM_V, pa0, pa1, pa2, pa3); partialSM(pA0, pA1, m_reg, mnA, alA);
    __syncthreads(); SWAIT(); SWRITE(1, SO);
    RESC(alA); __syncthreads();
  }
  SBAR(); qkt8(pB0, pB1, K_lds + SHM_K, qf, r32, hi);
  finishSM(pA0, pA1, alA, l_reg, pa0, pa1, pa2, pa3); SBAR();
  pv_d0(o, vb0, pa0, pa1, pa2, pa3); partialSM(pB0, pB1, m_reg, mnB, alB);
  __syncthreads(); RESC(alB);
  finishSM(pB0, pB1, alB, l_reg, pa0, pa1, pa2, pa3); SBAR();
  pv_d0(o, vb0 + (int)SHM_V, pa0, pa1, pa2, pa3);
  if (hi == 0) li_l[r32] = l_reg; asm volatile("s_waitcnt lgkmcnt(0)" ::: "memory");
  float rli[16];
#pragma unroll
  for (int r = 0; r < 16; ++r) rli[r] = __builtin_amdgcn_rcpf(li_l[crow(r, hi)]);
  bf16_t* Ow = Ob + (long)(wid * QBLK) * LDO;
#pragma unroll
  for (int r = 0; r < 16; ++r) { int orow = crow(r, hi);
#pragma unroll
    for (int d0 = 0; d0 < 4; ++d0) { const float v = o[d0][r] * rli[r]; Ow[(long)orow * LDO + d0 * 32 + r32] = (bf16_t)(cvt_pk_bf16(v, v) & 0xffffu); } }
  __syncthreads();
#undef SLOAD
#undef SWRITE
#undef SWAIT
#undef RESC
}
}

struct Args { const float* in[21]; float* out; unsigned char* ws; int ph_lo, ph_hi; };
enum { I_X = 0, I_C, I_CTX, I_CCTX, I_WMOD, I_BMOD, I_GN1, I_WIN, I_BIN, I_GQ, I_GK, I_GML, I_WOUT, I_GN2, I_WR, I_BR, I_W1, I_B1, I_W2, I_B2, I_GF };
struct Frame { LAS unsigned char* lds; char* ldsg; int tid, lane, wave, vcu, G; unsigned char* ws; };
constexpr int NWAVES = 8, NTHR = 512;

__device__ __forceinline__ void cvt_item(const float* __restrict__ W, int ldw, bf16_t* __restrict__ WT, int item, int nblk, int lane) {
    const int kb = item / nblk, nb = item - kb * nblk, k0 = 64 * kb, n0 = 32 * nb, kg = lane >> 3, ng = lane & 7;
    const float* src = W + (size_t)(k0 + 8 * kg) * ldw + n0 + 4 * ng;
    f32x4 v[8];
#pragma unroll
    for (int i = 0; i < 8; ++i) v[i] = __builtin_nontemporal_load((const f32x4*)(src + (size_t)i * ldw));
    bf16_t* dst = WT + (size_t)(n0 + 4 * ng) * 2048 + k0 + 8 * kg;
#pragma unroll
    for (int j = 0; j < 4; ++j) { u32x4 w; w.x = cvt_pk_bf16(v[0][j], v[1][j]); w.y = cvt_pk_bf16(v[2][j], v[3][j]); w.z = cvt_pk_bf16(v[4][j], v[5][j]); w.w = cvt_pk_bf16(v[6][j], v[7][j]);
        __builtin_nontemporal_store(w, (u32x4*)(dst + (size_t)j * 2048)); }
}
template <bool WT_SC1>
__device__ __forceinline__ void cvt_item8(const float* __restrict__ W, int ldw, unsigned char* __restrict__ WT, int kb, int n0, int lane, float scale = 64.0f) {
    const int k0 = 128 * kb, kg = lane >> 3, ng = lane & 7;
    const float* src = W + (size_t)(k0 + 16 * kg) * ldw + n0 + 4 * ng;
    f32x4 v[16];
#pragma unroll
    for (int i = 0; i < 16; ++i) v[i] = __builtin_nontemporal_load((const f32x4*)(src + (size_t)i * ldw)) * scale;
    unsigned char* dst = WT + (size_t)(n0 + 4 * ng) * 2048 + k0 + 16 * kg;
#pragma unroll
    for (int j = 0; j < 4; ++j) { int w[4];
#pragma unroll
        for (int q = 0; q < 4; ++q) { w[q] = 0; w[q] = __builtin_amdgcn_cvt_pk_fp8_f32(v[4 * q][j], v[4 * q + 1][j], w[q], false); w[q] = __builtin_amdgcn_cvt_pk_fp8_f32(v[4 * q + 2][j], v[4 * q + 3][j], w[q], true); }
        const u32x4 o = {(unsigned)w[0], (unsigned)w[1], (unsigned)w[2], (unsigned)w[3]};
        if constexpr (WT_SC1) { const __amdgpu_buffer_rsrc_t rs = __builtin_amdgcn_make_buffer_rsrc((void*)WT, 0, 4096 * 2048, 0x00020000);
            __builtin_amdgcn_raw_buffer_store_b128(o, rs, (unsigned)((n0 + 4 * ng + j) * 2048 + k0 + 16 * kg), 0, 16); }
        else __builtin_nontemporal_store(o, (u32x4*)(dst + (size_t)j * 2048)); }
}
__device__ __forceinline__ void cvt_dispatch(const Args& a, unsigned char* ws, int it, int lane) {
    constexpr int NB_SKIP = ATTN_PROJ8 ? 48 : 0;
    constexpr int I_IN = INPROJ_FP8 ? 16 * 144 : 32 * (144 - NB_SKIP), I_IN8 = ATTN_PROJ8 ? 16 * 48 : 0, I_OUT = PROJ_FP8 ? 16 * 64 : 32 * 64;
    int r = it;
    if (r < I_IN) {
#if INPROJ_FP8
        cvt_item8<false>(a.in[I_WIN], IN_COLS, ws + WS_WINT, r / 144, 32 * (r % 144), lane);
#else
        cvt_item(a.in[I_WIN] + 32 * NB_SKIP, IN_COLS, (bf16_t*)(ws + WS_WINT) + (size_t)(32 * NB_SKIP) * DM, r, 144 - NB_SKIP, lane);
#endif
        return; }
    r -= I_IN;
    if (r < I_IN8) { cvt_item8<false>(a.in[I_WIN], IN_COLS, ws + WS_WIN8, r / 48, 32 * (r % 48), lane); return; }
    r -= I_IN8;
    if (r < I_OUT) {
#if PROJ_FP8
        const int kb = r >> 6; cvt_item8<false>(a.in[I_WOUT], DM, ws + WS_WOUTT, kb, 32 * (r & 63), lane, kb < 8 ? 8.0f : 64.0f);
#else
        cvt_item(a.in[I_WOUT], DM, (bf16_t*)(ws + WS_WOUTT), r, 64, lane);
#endif
        return; }
}
constexpr int CVT_NITEMS = (INPROJ_FP8 ? 16 * 144 : 32 * (144 - (ATTN_PROJ8 ? 48 : 0))) + (ATTN_PROJ8 ? 16 * 48 : 0) + (PROJ_FP8 ? 16 * 64 : 32 * 64);
__device__ __forceinline__ void p0_phase(const Args& a, Frame& F) {
    float* mod = (float*)(F.ws + WS_MOD);
    for (int wg = F.vcu; wg < 192; wg += F.G) {
        LAS float* sil = (LAS float*)F.lds; LAS float* red = (LAS float*)(F.lds + 24576);
        __syncthreads();
        for (int idx = F.tid; idx < 3 * 2048; idx += NTHR) { const float v = idx < 4096 ? a.in[I_C][idx] : a.in[I_CCTX][idx - 4096]; sil[idx] = v / (1.0f + __expf(-v)); }
        __syncthreads();
        const int kg = F.tid >> 4, cq = F.tid & 15, col = 64 * wg + 4 * cq;
        f32x4 acc[3] = {};
        const float* wp = a.in[I_WMOD] + (size_t)(kg * 64) * 12288 + col;
#pragma unroll 8
        for (int kk = 0; kk < 64; ++kk) { const f32x4 w = __builtin_nontemporal_load((const f32x4*)(wp + (size_t)kk * 12288)); const int k = kg * 64 + kk;
            acc[0] += sil[k] * w; acc[1] += sil[2048 + k] * w; acc[2] += sil[4096 + k] * w; }
#pragma unroll
        for (int r = 0; r < 3; ++r)
#pragma unroll
            for (int j = 0; j < 4; ++j) red[(kg * 3 + r) * 64 + 4 * cq + j] = acc[r][j];
        __syncthreads();
        if (F.tid < 192) { const int r = F.tid >> 6, cc = F.tid & 63; float s = 0.f;
            for (int g = 0; g < 32; ++g) s += red[(g * 3 + r) * 64 + cc];
            mod[r * 12288 + 64 * wg + cc] = s + a.in[I_BMOD][64 * wg + cc]; }
    }
    const int gw = F.vcu * NWAVES + F.wave, NGW = F.G * NWAVES;
    {
#if INPROJ_FP8 || PROJ_FP8
        unsigned char* WT = F.ws + WS_WINT + (size_t)PW * DM;
        for (int idx = F.vcu * NTHR + F.tid; idx < 256 * DM; idx += F.G * NTHR) { const int n = idx >> 11, k = idx & 2047;
            const float v = n < 16 ? 64.0f * a.in[I_WIN][(size_t)k * IN_COLS + C_G + n] : 0.f; WT[idx] = (unsigned char)(__builtin_amdgcn_cvt_pk_fp8_f32(v, v, 0, false) & 0xff); }
#else
        bf16_t* WT = (bf16_t*)(F.ws + WS_WINT) + (size_t)PW * DM;
        for (int idx = F.vcu * NTHR + F.tid; idx < 256 * DM; idx += F.G * NTHR) { const int n = idx >> 11, k = idx & 2047;
            const float v = n < 16 ? a.in[I_WIN][(size_t)k * IN_COLS + C_G + n] : 0.f; WT[idx] = (bf16_t)(cvt_pk_bf16(v, v) & 0xffffu); }
#endif
    }
    for (int it = gw; it < CVT_NITEMS; it += NGW) cvt_dispatch(a, F.ws, it, F.lane);
}

__device__ __forceinline__ void p1_phase(const Args& a, Frame& F) {
    const float* mod = (const float*)(F.ws + WS_MOD);
    const int gw = F.vcu * NWAVES + F.wave, NGW = F.G * NWAVES;
    bf16_t* H = (bf16_t*)(F.ws + WS_H);
    for (int R = gw; R < MROWS; R += NGW) {
        const int b = R / ROWS_B, r = R - b * ROWS_B; const bool lat = r < SEQ;
        const float* src = lat ? a.in[I_X] + ((size_t)(b * SEQ + r)) * DM : a.in[I_CTX] + ((size_t)(b * CTXL + r - SEQ)) * DM;
        const float* mrow = mod + (size_t)(lat ? b : 2) * 12288;
        f32x4 v[8], gg[8], scv[8], shv[8]; float ss = 0.f;
#pragma unroll
        for (int j = 0; j < 8; ++j) { const int k = 4 * F.lane + 256 * j; v[j] = *(const f32x4*)(src + k); gg[j] = *(const f32x4*)(a.in[I_GN1] + k); scv[j] = *(const f32x4*)(mrow + 2048 + k); shv[j] = *(const f32x4*)(mrow + k); }
        __builtin_amdgcn_sched_barrier(0);
#pragma unroll
        for (int j = 0; j < 8; ++j) ss += (v[j].x * v[j].x + v[j].y * v[j].y) + (v[j].z * v[j].z + v[j].w * v[j].w);
        const float rstd = 1.0f / sqrtf(wave_sum(ss) * (1.0f / DM) + EPS);
#pragma unroll
        for (int j = 0; j < 8; ++j) { const int k = 4 * F.lane + 256 * j;
            const f32x4 g = gg[j], sc = scv[j], sh = shv[j];
            const f32x4 hv = v[j] * rstd * g * (sc + 1.0f) + sh;
#if INPROJ_FP8 || PROJ_FP8
            int w = 0; w = __builtin_amdgcn_cvt_pk_fp8_f32(hv.x, hv.y, w, false); w = __builtin_amdgcn_cvt_pk_fp8_f32(hv.z, hv.w, w, true);
            *(int*)((unsigned char*)H + (size_t)R * DM + k) = w; }
#else
            u32x2 w; w.x = cvt_pk_bf16(hv.x, hv.y); w.y = cvt_pk_bf16(hv.z, hv.w);
            *(u32x2*)(H + (size_t)R * DM + k) = w;
#if ATTN_PROJ8
            { int w8 = 0; w8 = __builtin_amdgcn_cvt_pk_fp8_f32(hv.x, hv.y, w8, false); w8 = __builtin_amdgcn_cvt_pk_fp8_f32(hv.z, hv.w, w8, true); *(int*)(F.ws + WS_H8 + (size_t)R * DM + k) = w8; }
#endif
            }
#endif
    }

}

__device__ __forceinline__ float wave_scan_add(float v, int lane) {
#pragma unroll
    for (int o = 1; o < 64; o <<= 1) { const float t = __shfl_up(v, o); if (lane >= o) v += t; }
    return v;
}
__device__ __forceinline__ float wave_scan_max(float v, int lane) {
#pragma unroll
    for (int o = 1; o < 64; o <<= 1) { const float t = __shfl_up(v, o); if (lane >= o) v = fmaxf(v, t); }
    return v;
}
__device__ __forceinline__ float log_sigmoid(float f) { return fminf(f, 0.f) - log1pf(__expf(-fabsf(f))); }
__device__ __forceinline__ void chunk_scan_task(const float* gate, float* GA, float* GM, float* GB, float* GC, int chain, int tb, int lane, LAS float* a_lds, LAS float* amax_lds) {
    const int b = chain >> 3, dir = (chain >> 2) & 1, h = chain & 3;
    const int j0 = 2 * lane, j1 = j0 + 1;
    const int s0 = dir == 0 ? j0 : 127 - j0, s1i = dir == 0 ? j1 : 127 - j1; const int r0 = tb * 128 + s0, r1 = tb * 128 + s1i;
    const float* g0 = gate + (size_t)(b * ROWS_B + r0) * 16; const float* g1 = gate + (size_t)(b * ROWS_B + r1) * 16;
    const float lf0 = log_sigmoid(g0[8 + dir * 4 + h]), lf1 = log_sigmoid(g1[8 + dir * 4 + h]), i0 = g0[dir * 4 + h], i1 = g1[dir * 4 + h];
    const float s1 = lf0 + lf1; const float incl = wave_scan_add(s1, lane), excl = incl - s1;
    const float b0 = excl + lf0, b1 = excl + s1;
    const float a0 = i0 - b0, a1 = i1 - b1; const float m1 = fmaxf(a0, a1);
    const float im = wave_scan_max(m1, lane); float ex = __shfl_up(im, 1); if (lane == 0) ex = -3.0e38f;
    const float c0 = fmaxf(ex, a0), c1 = fmaxf(ex, m1);
    const size_t o = (size_t)chain * ROWS_B;
    GA[o + r0] = a0; GA[o + r1] = a1; GM[o + r0] = c0; GM[o + r1] = c1; GB[o + r0] = b0; GB[o + r1] = b1;
    if (lane == 63) { float* gc = GC + (size_t)(chain * NTB + tb) * 4; gc[0] = b1; gc[1] = c1; }
    if (a_lds != nullptr) { a_lds[s0] = a0; a_lds[s1i] = a1; if (lane == 63) amax_lds[0] = c1; }
}
__device__ __forceinline__ void p3_phase(const Args& a, Frame& F) {
    LAS float* cs = (LAS float*)F.lds; LAS float* sn = (LAS float*)(F.lds + 8192);
    LAS float* gi = (LAS float*)(F.lds + 16384); LAS float* gf = (LAS float*)(F.lds + 16384 + 17408);
    __syncthreads();
    for (int idx = F.tid; idx < 2048; idx += NTHR) { const int pos = idx >> 5, fi = idx & 31; const float inv = exp2f(-(float)fi * 0.41524101186092029f); const float ang = (float)pos * inv;
        cs[idx] = cosf(ang); sn[idx] = sinf(ang); }
    __syncthreads();
    bf16_t* P = (bf16_t*)(F.ws + WS_P);
    const int gw = F.vcu * NWAVES + F.wave, NGW = F.G * NWAVES;
    const int sub = F.lane >> 4, l16 = F.lane & 15, e0 = 8 * l16;
    for (int R = gw; R < MROWS; R += NGW) {
        const int b = R / ROWS_B, r = R - b * ROWS_B; const bool lat = r < SEQ;
        u32x4 raws[3]; bool act[3]; bf16_t* ptr[3];
#pragma unroll
        for (int step = 0; step < 3; ++step) {
            const int s_ = step * 4 + sub; const bool isq = s_ < 8; act[step] = isq ? lat : (s_ < 10);
            const int colb = isq ? s_ * 128 : C_K + (s_ - 8) * 128;
            ptr[step] = P + (size_t)R * PW + colb + e0;
            raws[step] = (u32x4){0u, 0u, 0u, 0u}; if (act[step]) raws[step] = *(const u32x4*)ptr[step];
        }
        __builtin_amdgcn_sched_barrier(0);
#pragma unroll
        for (int step = 0; step < 3; ++step) {
            const int s_ = step * 4 + sub; const bool isq = s_ < 8; const u32x4 raw = raws[step];
            float y[8]; y[0] = bflo(raw.x); y[1] = bfhi(raw.x); y[2] = bflo(raw.y); y[3] = bfhi(raw.y); y[4] = bflo(raw.z); y[5] = bfhi(raw.z); y[6] = bflo(raw.w); y[7] = bfhi(raw.w);
            float ss = 0.f;
#pragma unroll
            for (int i = 0; i < 8; ++i) ss += y[i] * y[i];
            ss += __shfl_xor(ss, 1); ss += __shfl_xor(ss, 2); ss += __shfl_xor(ss, 4); ss += __shfl_xor(ss, 8);
            const float rstd = 1.0f / sqrtf(ss * (1.0f / HD) + EPS);
            const float* g = (isq ? a.in[I_GQ] : a.in[I_GK]) + e0;
#pragma unroll
            for (int i = 0; i < 8; ++i) y[i] = y[i] * rstd * g[i];
            if (lat) {
                const int posr = r >> 6, posc = r & 63;
#pragma unroll
                for (int i = 0; i < 4; ++i) { const int pp = 4 * l16 + i; const int pos = pp < 32 ? posr : posc; const int ti = pos * 32 + (pp & 31);
                    const float c = cs[ti], sv = sn[ti]; const float x1 = y[2 * i], x2 = y[2 * i + 1]; y[2 * i] = x1 * c - x2 * sv; y[2 * i + 1] = x1 * sv + x2 * c; }
            }
#if ATT_QK8
            if (act[step]) { int w0 = 0, w1 = 0;
                w0 = __builtin_amdgcn_cvt_pk_fp8_f32(y[0], y[1], w0, false); w0 = __builtin_amdgcn_cvt_pk_fp8_f32(y[2], y[3], w0, true);
                w1 = __builtin_amdgcn_cvt_pk_fp8_f32(y[4], y[5], w1, false); w1 = __builtin_amdgcn_cvt_pk_fp8_f32(y[6], y[7], w1, true);
                unsigned char* dst = isq ? F.ws + WS_Q8 + ((size_t)(b * SEQ + r)) * 1024 + s_ * 128 + e0 : F.ws + WS_K8 + (size_t)R * 256 + (s_ - 8) * 128 + e0;
                *(u32x2*)dst = (u32x2){(unsigned)w0, (unsigned)w1}; }
#else
            if (act[step]) { u32x4 w; w.x = cvt_pk_bf16(y[0], y[1]); w.y = cvt_pk_bf16(y[2], y[3]); w.z = cvt_pk_bf16(y[4], y[5]); w.w = cvt_pk_bf16(y[6], y[7]); *(u32x4*)ptr[step] = w; }
#endif
        }
    }
    const float* mod = (const float*)(F.ws + WS_MOD);
    float* wrs = (float*)(F.ws + WS_WRS);
    for (int idx = F.vcu * NTHR + F.tid; idx < 2 * 65536; idx += F.G * NTHR) { const int b = idx >> 16, k = (idx >> 5) & 2047;
        wrs[idx] = a.in[I_GN2][k] * (1.0f + mod[b * 12288 + 8192 + k]) * a.in[I_WR][idx & 65535]; }
    for (int be = F.vcu; be < 64; be += F.G) {
        const int b = be >> 5, e = be & 31; float s = 0.f;
#pragma unroll
        for (int i = 0; i < 4; ++i) { const int k = F.tid + NTHR * i; s += mod[b * 12288 + 6144 + k] * a.in[I_WR][k * 32 + e]; }
        s = wave_sum(s);
        LAS float* red = (LAS float*)F.lds;
        __syncthreads();
        if (F.lane == 0) red[F.wave] = s;
        __syncthreads();
        if (F.tid == 0) { float t = 0.f; for (int w = 0; w < NWAVES; ++w) t += red[w]; wrs[2 * 65536 + be] = t + a.in[I_BR][e]; }
    }
}

__device__ __forceinline__ int chain_tb(int dir, int c) { return dir == 0 ? (c < 2 ? 32 + c : c - 2) : 33 - c; }
__device__ __forceinline__ int chain_pos(int dir, int tb) { return dir == 0 ? (tb < 32 ? tb + 2 : tb - 32) : 33 - tb; }
__device__ __forceinline__ void chain_scan(const float* GC, int chain, int dir, int lane, float& mp_c, float& am_c) {
    const int c = lane < NTB ? lane : NTB - 1; const float* gc = GC + (size_t)(chain * NTB + chain_tb(dir, c)) * 4;
    const float x = gc[0], y = gc[1]; float m = 0.f, mp = 0.f;
#pragma unroll
    for (int i = 0; i < NTB; ++i) { if (lane == i) mp = m; m = __shfl(x, i) + fmaxf(m, __shfl(y, i)); }
    mp_c = mp; am_c = y;
}

__device__ __forceinline__ void p4_phase(const Args& a, Frame& F) {
    using namespace att;
    const bf16_t* P = (const bf16_t*)(F.ws + WS_P);
    const float* GA = (const float*)(F.ws + WS_GA); const float* GC = (const float*)(F.ws + WS_GC);
    float* LST = (float*)(F.ws + WS_LST); float* NL = (float*)(F.ws + WS_NL);
    char* Vimg = F.ldsg; char* Kimg = F.ldsg + 65536; LAS float* wsc = (LAS float*)(F.lds + TAB_OFF);
    for (int u = F.vcu; u < NB * MH * NTB; u += F.G) {
        const int b = u / (MH * NTB), h = (u / NTB) % MH, tb = u % NTB;
        int tid = F.tid; asm volatile("" : "+v"(tid));
        const int lane = tid & 63, r32 = lane & 31, hi = lane >> 5;
        const size_t rowbase = (size_t)b * ROWS_B + tb * 128;
        __syncthreads();
        if (F.wave < 2) chunk_scan_task((const float*)(F.ws + WS_GATE), (float*)(F.ws + WS_GA), (float*)(F.ws + WS_GM), (float*)(F.ws + WS_GB), (float*)(F.ws + WS_GC),
                                        (b * 2 + F.wave) * 4 + h, tb, lane, wsc + 512 + F.wave * 128, wsc + 256 + F.wave);
        __syncthreads();
        if (tid < 256) { const int dir = tid >> 7;
            wsc[tid] = 0.088388347648318440f * __expf(wsc[512 + tid] - wsc[256 + dir]); }
        __syncthreads();
        bf16x8 sv[8]; u32x4 sk[4];
#pragma unroll
        for (int i = 0; i < 8; ++i) { const int p = tid + NTHR * i, s = p >> 5, c8 = (p & 31) * 8; sv[i] = *(const bf16x8*)(P + (rowbase + s) * PW + C_MV + h * 256 + c8); }
#pragma unroll
        for (int i = 0; i < 4; ++i) { const int p = tid + NTHR * i, s = p >> 4, c8 = (p & 15) * 8; sk[i] = *(const u32x4*)(P + (rowbase + s) * PW + C_MK + h * 128 + c8); }
        __builtin_amdgcn_sched_barrier(0);
#pragma unroll
        for (int i = 0; i < 8; ++i) { const int p = tid + NTHR * i, s = p >> 5, c8 = (p & 31) * 8;
            *(bf16x8*)(Vimg + ((s >> 6) * 2 + (c8 >> 7)) * 16384 + v_st(s & 63, c8 & 127)) = sv[i]; }
#pragma unroll
        for (int i = 0; i < 4; ++i) { const int p = tid + NTHR * i, s = p >> 4, c8 = (p & 15) * 8;
            const u32x4 raw = sk[i];
            float y[8]; y[0] = bflo(raw.x); y[1] = bfhi(raw.x); y[2] = bflo(raw.y); y[3] = bfhi(raw.y); y[4] = bflo(raw.z); y[5] = bfhi(raw.z); y[6] = bflo(raw.w); y[7] = bfhi(raw.w);
#pragma unroll
            for (int dir = 0; dir < 2; ++dir) { const float w = wsc[dir * 128 + s];
                u32x4 o; o.x = cvt_pk_bf16(y[0] * w, y[1] * w); o.y = cvt_pk_bf16(y[2] * w, y[3] * w); o.z = cvt_pk_bf16(y[4] * w, y[5] * w); o.w = cvt_pk_bf16(y[6] * w, y[7] * w);
                *(u32x4*)(Kimg + (dir * 2 + (s >> 6)) * 16384 + v_st(s & 63, c8)) = o; } }
        __syncthreads();
        const int vh = F.wave >> 2, vb = F.wave & 3;
        f32x16 acc[2][4];
#pragma unroll
        for (int d = 0; d < 2; ++d)
#pragma unroll
            for (int q = 0; q < 4; ++q) acc[d][q] = f32x16{};
#pragma unroll
        for (int kt = 0; kt < 2; ++kt) {
            const int baseA = (int)(uintptr_t)Vimg + (kt * 2 + vh) * 16384 + vb * 512 + v_rd_base(lane);
            const int baseB0 = (int)(uintptr_t)Kimg + (0 * 2 + kt) * 16384 + v_rd_base(lane);
            const int baseB1 = (int)(uintptr_t)Kimg + (1 * 2 + kt) * 16384 + v_rd_base(lane);
#define P4_STEP(KS) do { \
            const s16x4 al = tr_read<v_rd_off(0, KS, 0)>(baseA), ah = tr_read<v_rd_off(0, KS, 1)>(baseA); \
            const s16x4 b00l = tr_read<v_rd_off(0, KS, 0)>(baseB0), b00h = tr_read<v_rd_off(0, KS, 1)>(baseB0), b01l = tr_read<v_rd_off(1, KS, 0)>(baseB0), b01h = tr_read<v_rd_off(1, KS, 1)>(baseB0); \
            const s16x4 b02l = tr_read<v_rd_off(2, KS, 0)>(baseB0), b02h = tr_read<v_rd_off(2, KS, 1)>(baseB0), b03l = tr_read<v_rd_off(3, KS, 0)>(baseB0), b03h = tr_read<v_rd_off(3, KS, 1)>(baseB0); \
            const s16x4 b10l = tr_read<v_rd_off(0, KS, 0)>(baseB1), b10h = tr_read<v_rd_off(0, KS, 1)>(baseB1), b11l = tr_read<v_rd_off(1, KS, 0)>(baseB1), b11h = tr_read<v_rd_off(1, KS, 1)>(baseB1); \
            const s16x4 b12l = tr_read<v_rd_off(2, KS, 0)>(baseB1), b12h = tr_read<v_rd_off(2, KS, 1)>(baseB1), b13l = tr_read<v_rd_off(3, KS, 0)>(baseB1), b13h = tr_read<v_rd_off(3, KS, 1)>(baseB1); \
            asm volatile("s_waitcnt lgkmcnt(0)" ::: "memory"); SBAR(); \
            const bf16x8 af = PKLH(al, ah); \
            acc[0][0] = __builtin_amdgcn_mfma_f32_32x32x16_bf16(af, PKLH(b00l, b00h), acc[0][0], 0, 0, 0); acc[0][1] = __builtin_amdgcn_mfma_f32_32x32x16_bf16(af, PKLH(b01l, b01h), acc[0][1], 0, 0, 0); \
            acc[0][2] = __builtin_amdgcn_mfma_f32_32x32x16_bf16(af, PKLH(b02l, b02h), acc[0][2], 0, 0, 0); acc[0][3] = __builtin_amdgcn_mfma_f32_32x32x16_bf16(af, PKLH(b03l, b03h), acc[0][3], 0, 0, 0); \
            acc[1][0] = __builtin_amdgcn_mfma_f32_32x32x16_bf16(af, PKLH(b10l, b10h), acc[1][0], 0, 0, 0); acc[1][1] = __builtin_amdgcn_mfma_f32_32x32x16_bf16(af, PKLH(b11l, b11h), acc[1][1], 0, 0, 0); \
            acc[1][2] = __builtin_amdgcn_mfma_f32_32x32x16_bf16(af, PKLH(b12l, b12h), acc[1][2], 0, 0, 0); acc[1][3] = __builtin_amdgcn_mfma_f32_32x32x16_bf16(af, PKLH(b13l, b13h), acc[1][3], 0, 0, 0); \
        } while (0)
            P4_STEP(0); P4_STEP(1); P4_STEP(2); P4_STEP(3);
#undef P4_STEP
        }
#pragma unroll
        for (int dir = 0; dir < 2; ++dir) { const int chain = (b * 2 + dir) * 4 + h; float* Lp = LST + ((size_t)(chain * NTB + tb) * 256 + 32 * F.wave) * 128;
#pragma unroll
            for (int q = 0; q < 4; ++q)
#pragma unroll
                for (int rr = 0; rr < 16; ++rr) Lp[(size_t)crow(rr, hi) * 128 + 32 * q + r32] = acc[dir][q][rr]; }
        if (tid < 256) { const int dir = tid >> 7, d = tid & 127; const int chain = (b * 2 + dir) * 4 + h; float s = 0.f;
            for (int ss = 0; ss < 128; ++ss) s += bf2f(*(const unsigned short*)(Kimg + (dir * 2 + (ss >> 6)) * 16384 + v_st(ss & 63, d & ~7) + (d & 7) * 2));
            NL[(size_t)(chain * NTB + tb) * 128 + d] = s; }
    }
    __syncthreads();
}

__device__ __forceinline__ void p5_phase(const Args& a, Frame& F) {
    const float* __restrict__ LST = (const float*)(F.ws + WS_LST); const float* __restrict__ NL = (const float*)(F.ws + WS_NL); const float* GC = (const float*)(F.ws + WS_GC); float* GCw = (float*)(F.ws + WS_GC);
    bf16_t* __restrict__ CST = (bf16_t*)(F.ws + WS_CST); float* __restrict__ NST = (float*)(F.ws + WS_NST);
    for (int u = F.vcu; u < NCHAIN * 16; u += F.G) {
        const int chain = u >> 4, part = u & 15, dir = (chain >> 2) & 1; const size_t e0 = (size_t)part * 2048 + F.tid * 4;
        LAS float* dec_l = (LAS float*)F.lds;
        __syncthreads();
        if (F.wave == 0) { float mp, am; chain_scan(GC, chain, dir, F.lane, mp, am);
            if (F.lane < NTB) { const float MT = fmaxf(mp, am); dec_l[F.lane] = __expf(mp - MT); dec_l[64 + F.lane] = __expf(am - MT);
                if (part == 0) GCw[(size_t)(chain * NTB + chain_tb(dir, F.lane)) * 4 + 2] = mp; } }
        __syncthreads();
        f32x4 C = {0.f, 0.f, 0.f, 0.f}; float n = 0.f; const bool don = (part == 0 && F.tid < 128);
#pragma unroll 2
        for (int c = 0; c < NTB; ++c) {
            const int tb = dir == 0 ? (c < 2 ? 32 + c : c - 2) : 33 - c;
            if (tb < 32) { u32x2 w; w.x = cvt_pk_bf16(C.x, C.y); w.y = cvt_pk_bf16(C.z, C.w); *(u32x2*)(CST + (size_t)(chain * 32 + tb) * 32768 + e0) = w;
                if (don) NST[(size_t)(chain * 32 + tb) * 128 + F.tid] = n; }
            if (c < NTB - 1) { const float dec = dec_l[c], fac = dec_l[64 + c];
                const f32x4 L = *(const f32x4*)(LST + (size_t)(chain * NTB + tb) * 32768 + e0); C = dec * C + fac * L;
                if (don) n = dec * n + fac * NL[(size_t)(chain * NTB + tb) * 128 + F.tid]; }
        }
    }
}

__device__ __forceinline__ void p6_attention(const Args& a, Frame& F) {
    const bf16_t* P = (const bf16_t*)(F.ws + WS_P); bf16_t* Y = (bf16_t*)(F.ws + WS_Y);
    for (int u = F.vcu; u < 256; u += F.G) {
        const int x = u >> 5, idx = u & 31, b = x >> 2, kvh = (x >> 1) & 1, qhalf = x & 1, g = idx >> 3, qblk = qhalf * 8 + (idx & 7), head = kvh * 4 + g;
        const bf16_t* Qb = P + ((size_t)b * ROWS_B + qblk * 256) * PW + C_Q + head * 128;
        const bf16_t* Kh = P + ((size_t)b * ROWS_B) * PW + C_K + kvh * 128;
        const bf16_t* Vh = P + ((size_t)b * ROWS_B) * PW + C_V + kvh * 128;
        __syncthreads();
#if PROJ_FP8
        att::attn_dense_body<PW, PW, DM, true>(Qb, Kh, Vh, (unsigned char*)Y + ((size_t)b * SEQ + qblk * 256) * DM + head * 128, ROWS_B, F.ldsg);
#else
#if ATT_QK8
        att::attn_dense_body_q8<1024, 256, PW, DM>(F.ws + WS_Q8 + ((size_t)b * SEQ + qblk * 256) * 1024 + head * 128, F.ws + WS_K8 + ((size_t)b * ROWS_B) * 256 + kvh * 128, Vh,
                                                   Y + ((size_t)b * SEQ + qblk * 256) * DM + head * 128, ROWS_B, F.ldsg);
#else
        att::attn_dense_body<PW, PW, DM, false>(Qb, Kh, Vh, Y + ((size_t)b * SEQ + qblk * 256) * DM + head * 128, ROWS_B, F.ldsg);
#endif
#endif
    }
}
__device__ __forceinline__ void p6_mlstm_out(const Args& a, Frame& F) {
    using namespace att;
    const bf16_t* P = (const bf16_t*)(F.ws + WS_P); bf16_t* Y = (bf16_t*)(F.ws + WS_Y);
    const float* GA = (const float*)(F.ws + WS_GA); const float* GM = (const float*)(F.ws + WS_GM); const float* GB = (const float*)(F.ws + WS_GB); const float* GC = (const float*)(F.ws + WS_GC);
    const bf16_t* CST = (const bf16_t*)(F.ws + WS_CST); const float* NST = (const float*)(F.ws + WS_NST);
    char* Vimg = F.ldsg; char* Kimg = F.ldsg + 65536;
    LAS float* ga_l = (LAS float*)(F.lds + 98304);
    LAS float* nst_l = (LAS float*)(F.lds + 98304 + 1024);
    LAS float* xw = (LAS float*)(F.lds + 98304 + 2048);
    LAS float* ssx = (LAS float*)(F.lds + 98304 + 4096);
    LAS float* mpv = (LAS float*)(F.lds + 98304 + 5120);
    const int wq = F.wave & 1, vq = F.wave >> 1, vh = vq >> 1, vsub = vq & 1;
    LAS float* myx = xw + F.wave * 64;
    for (int u = F.vcu; u < NB * MH * 32; u += F.G) {
        const int b = u >> 7, h = (u >> 5) & 3, lb = u & 31;
        int tid = F.tid; asm volatile("" : "+v"(tid));
        const int lane = tid & 63, r32 = lane & 31, hi = lane >> 5;
        const size_t rowbase = (size_t)b * ROWS_B + lb * 128;
        __syncthreads();
        { bf16x8 sv[8], sk[4];
#pragma unroll
          for (int i = 0; i < 8; ++i) { const int p = tid + NTHR * i, s = p >> 5, c8 = (p & 31) * 8; sv[i] = *(const bf16x8*)(P + (rowbase + s) * PW + C_MV + h * 256 + c8); }
#pragma unroll
          for (int i = 0; i < 4; ++i) { const int p = tid + NTHR * i, s = p >> 4, c8 = (p & 15) * 8; sk[i] = *(const bf16x8*)(P + (rowbase + s) * PW + C_MK + h * 128 + c8); }
          __builtin_amdgcn_sched_barrier(0);
#pragma unroll
          for (int i = 0; i < 8; ++i) { const int p = tid + NTHR * i, s = p >> 5, c8 = (p & 31) * 8; *(bf16x8*)(Vimg + ((s >> 6) * 2 + (c8 >> 7)) * 16384 + v_st(s & 63, c8 & 127)) = sv[i]; }
#pragma unroll
          for (int i = 0; i < 4; ++i) { const int p = tid + NTHR * i, s = p >> 4, c8 = (p & 15) * 8; *(bf16x8*)(Kimg + (s >> 6) * 16384 + KSWZ(s & 63, c8 * 2)) = sk[i]; } }
        if (tid < 256) { const int dir = tid >> 7, s = tid & 127; const int chain = (b * 2 + dir) * 4 + h;
            ga_l[tid] = GA[(size_t)chain * ROWS_B + lb * 128 + s]; nst_l[tid] = NST[(size_t)(chain * 32 + lb) * 128 + s]; }
        if (tid < 2) { const int chain = (b * 2 + tid) * 4 + h; mpv[tid] = GC[(size_t)(chain * NTB + lb) * 4 + 2]; }
#pragma unroll 1
        for (int rh = 0; rh < 2; ++rh) {
        if (rh) __syncthreads();
        int tid_h = tid; asm volatile("" : "+v"(tid_h));
        const int lane = tid_h & 63, r32 = lane & 31, hi = lane >> 5;
        const int t = rh * 64 + wq * 32 + r32;
        bf16x8 qr[8];
        { const bf16_t* Qw = P + (rowbase + t) * PW + C_MQ + h * 128 + hi * 8;
#pragma unroll
          for (int d0 = 0; d0 < 8; ++d0) qr[d0] = *reinterpret_cast<const bf16x8*>(Qw + d0 * 16); }
        __syncthreads();
        f32x16 hsum[2];
        hsum[0] = f32x16{}; hsum[1] = f32x16{};
#pragma unroll 1
        for (int dir = 0; dir < 2; ++dir) {
            const int chain = (b * 2 + dir) * 4 + h;
            const float mprev = mpv[dir];
            const float Mt = fmaxf(mprev, GM[(size_t)chain * ROWS_B + lb * 128 + t]), bt = GB[(size_t)chain * ROWS_B + lb * 128 + t];
            const float winter = __expf(mprev - Mt);
            f32x16 o[2]; o[0] = f32x16{}; o[1] = f32x16{};
            const bf16_t* Cb = CST + ((size_t)(chain * 32 + lb) * 256 + vq * 64 + r32) * 128 + hi * 8;
            { bf16x8 cf[8][2];
#pragma unroll
              for (int ds = 0; ds < 8; ++ds)
#pragma unroll
                for (int q = 0; q < 2; ++q) cf[ds][q] = *reinterpret_cast<const bf16x8*>(Cb + (size_t)q * 32 * 128 + ds * 16);
              __builtin_amdgcn_sched_barrier(0);
#pragma unroll
              for (int ds = 0; ds < 8; ++ds)
#pragma unroll
                for (int q = 0; q < 2; ++q) o[q] = __builtin_amdgcn_mfma_f32_32x32x16_bf16(qr[ds], cf[ds][q], o[q], 0, 0, 0); }
            float qn = 0.f;
#pragma unroll
            for (int ds = 0; ds < 8; ++ds)
#pragma unroll
                for (int j = 0; j < 8; ++j) qn += bf2f((unsigned short)qr[ds][j]) * nst_l[dir * 128 + ds * 16 + hi * 8 + j];
            { auto rr = __builtin_amdgcn_permlane32_swap(__float_as_uint(qn), __float_as_uint(qn), false, false); qn = __uint_as_float(rr[0]) + __uint_as_float(rr[1]); }
            if (hi == 0) myx[r32] = winter;
            LDS_WAIT();
#pragma unroll
            for (int rr = 0; rr < 16; ++rr) { const float w = myx[crow(rr, hi)]; o[0][rr] *= w; o[1][rr] *= w; }
            float rowsum = 0.f;
            int tt = t; asm volatile("" : "+v"(tt));
#pragma unroll
            for (int kt = 0; kt < 2; ++kt) {
                if ((dir == 0 && rh == 0 && kt == 1) || (dir == 1 && rh == 1 && kt == 0)) continue;
                f32x16 p0, p1;
                qkt(p0, p1, Kimg + kt * 16384, qr, r32, hi);
#pragma unroll
                for (int rr = 0; rr < 16; ++rr) {
                    const int s0 = kt * 64 + crow(rr, hi), s1 = s0 + 32;
                    const bool ok0 = dir == 0 ? (s0 <= tt) : (s0 >= tt), ok1 = dir == 0 ? (s1 <= tt) : (s1 >= tt);
                    const float e0 = __expf(ga_l[dir * 128 + s0] - Mt), e1 = __expf(ga_l[dir * 128 + s1] - Mt);
                    p0[rr] = ok0 ? p0[rr] * 0.088388347648318440f * e0 : 0.f; p1[rr] = ok1 ? p1[rr] * 0.088388347648318440f * e1 : 0.f;
                    rowsum += p0[rr] + p1[rr];
                }
                bf16x8 pa0, pa1, pa2, pa3;
                PK4(p0, 0, pa0); PK4(p0, 8, pa1); PK4(p1, 0, pa2); PK4(p1, 8, pa3);
                const int vbase = (int)(uintptr_t)Vimg + (kt * 2 + vh) * 16384 + vsub * 1024 + v_rd_base(lane);
                pv_one<0>(o[0], vbase, pa0, pa1, pa2, pa3); pv_one<1>(o[1], vbase, pa0, pa1, pa2, pa3);
            }
            { auto rr = __builtin_amdgcn_permlane32_swap(__float_as_uint(rowsum), __float_as_uint(rowsum), false, false); rowsum = __uint_as_float(rr[0]) + __uint_as_float(rr[1]); }
            const float den = rowsum + winter * qn;
            const float rinv = 1.0f / fmaxf(fabsf(den), __expf(-(bt + Mt)));
            LDS_WAIT();
            if (hi == 0) myx[32 + r32] = rinv;
            LDS_WAIT();
#pragma unroll
            for (int rr = 0; rr < 16; ++rr) { const float w = myx[32 + crow(rr, hi)]; hsum[0][rr] += o[0][rr] * w; hsum[1][rr] += o[1][rr] * w; }
        }
        float ssr[16];
#pragma unroll
        for (int rr = 0; rr < 16; ++rr) { float s = hsum[0][rr] * hsum[0][rr] + hsum[1][rr] * hsum[1][rr];
            s += __shfl_xor(s, 1); s += __shfl_xor(s, 2); s += __shfl_xor(s, 4); s += __shfl_xor(s, 8); s += __shfl_xor(s, 16); ssr[rr] = s; }
        if (r32 == 0) {
#pragma unroll
            for (int rr = 0; rr < 16; ++rr) ssx[vq * 64 + wq * 32 + crow(rr, hi)] = ssr[rr]; }
        __syncthreads();
        const float* gml = a.in[I_GML] + h * 256 + vq * 64 + r32;
        const float g0 = gml[0], g1 = gml[32];
        unsigned short mov[16][2];
#pragma unroll
        for (int rr = 0; rr < 16; ++rr) { const size_t prow = rowbase + rh * 64 + wq * 32 + crow(rr, hi);
#pragma unroll
            for (int q = 0; q < 2; ++q) mov[rr][q] = P[prow * PW + C_MO + h * 256 + vq * 64 + 32 * q + r32]; }
        __builtin_amdgcn_sched_barrier(0);
#pragma unroll
        for (int rr = 0; rr < 16; ++rr) { const int row = wq * 32 + crow(rr, hi);
            const float rn = 1.0f / sqrtf(((ssx[row] + ssx[64 + row]) + (ssx[128 + row] + ssx[192 + row])) * (1.0f / MDV) + EPS);
            const size_t yrow = (size_t)b * SEQ + lb * 128 + rh * 64 + row;
#pragma unroll
            for (int q = 0; q < 2; ++q) { const int v = vq * 64 + 32 * q + r32;
                const float mo = bf2f(mov[rr][q]);
                const float val = hsum[q][rr] * rn * (q == 0 ? g0 : g1) / (1.0f + __expf(-mo));
#if PROJ_FP8
                ((unsigned char*)Y)[yrow * DM + 1024 + h * 256 + v] = (unsigned char)(__builtin_amdgcn_cvt_pk_fp8_f32(val, val, 0, false) & 0xff); } }
#else
                Y[yrow * DM + 1024 + h * 256 + v] = (bf16_t)(cvt_pk_bf16(val, val) & 0xffffu); } }
#endif
        }
    }
    __syncthreads();
}

__device__ __forceinline__ void p8_phase(const Args& a, Frame& F) {
    using att::crow;
    const float* X1 = (const float*)(F.ws + WS_X1); const float* mod = (const float*)(F.ws + WS_MOD);
    const float* wrs = (const float*)(F.ws + WS_WRS);
    unsigned char* H2 = F.ws + WS_H;
    int* TOKE = (int*)(F.ws + WS_TOKE); int* TOKP = (int*)(F.ws + WS_TOKP); float* TOKW = (float*)(F.ws + WS_TOKW); int* LIST = (int*)(F.ws + WS_LIST);
    unsigned* ctl = (unsigned*)(F.ws + WS_CTL);
    LAS float* PL = (LAS float*)F.lds;
    LAS float* PSS = (LAS float*)(F.lds + 32768);
    LAS int* hist = (LAS int*)(F.lds + 32768 + 2048);
    LAS int* basee = hist + 32;
    LAS float* rstd_l = (LAS float*)(hist + 64);
    LAS int* selE = hist + 96; LAS int* selR = hist + 96 + 128; LAS float* selW = (LAS float*)(hist + 96 + 256);
    const int r32 = F.lane & 31, hi = F.lane >> 5;
    for (int blk = F.vcu; blk < NLAT / 32; blk += F.G) {
        const int tok0 = blk * 32, b = tok0 >> 12;
        const float* Wp = wrs + (size_t)b * 65536; const float* cb = wrs + 2 * 65536 + b * 32;
        __syncthreads();
        if (F.tid < 32) hist[F.tid] = 0;
        { const int k0 = 256 * F.wave; f32x16 acc = {}; float ssq = 0.f;
          const float* xr = X1 + (size_t)(tok0 + r32) * DM + k0 + 4 * hi;
#pragma unroll 4
          for (int q = 0; q < 32; ++q) { const f32x4 a4 = *(const f32x4*)(xr + 8 * q); const float* wq_ = Wp + (size_t)(k0 + 8 * q + 4 * hi) * 32 + r32;
              const float b0 = wq_[0], b1 = wq_[32], b2 = wq_[64], b3 = wq_[96];
              ssq += (a4.x * a4.x + a4.y * a4.y) + (a4.z * a4.z + a4.w * a4.w);
              acc = __builtin_amdgcn_mfma_f32_32x32x2f32(a4.x, b0, acc, 0, 0, 0); acc = __builtin_amdgcn_mfma_f32_32x32x2f32(a4.y, b1, acc, 0, 0, 0);
              acc = __builtin_amdgcn_mfma_f32_32x32x2f32(a4.z, b2, acc, 0, 0, 0); acc = __builtin_amdgcn_mfma_f32_32x32x2f32(a4.w, b3, acc, 0, 0, 0); }
#pragma unroll
          for (int rr = 0; rr < 16; ++rr) PL[(F.wave * 32 + crow(rr, hi)) * 32 + r32] = acc[rr];
          PSS[F.wave * 64 + F.lane] = ssq; }
        __syncthreads();
#pragma unroll 1
        for (int st = 0; st < 2; ++st) { const int row = 4 * F.wave + 2 * st + hi; float sum = 0.f, ss = 0.f;
#pragma unroll
            for (int ww = 0; ww < 8; ++ww) { sum += PL[(ww * 32 + row) * 32 + r32]; ss += PSS[ww * 64 + row] + PSS[ww * 64 + 32 + row]; }
            const float rstd = 1.0f / sqrtf(ss * (1.0f / DM) + EPS);
            float v = rstd * sum + cb[r32];
            float vals[4]; int ids[4];
#pragma unroll
            for (int k = 0; k < 4; ++k) { float m = v;
#pragma unroll
                for (int o = 1; o < 32; o <<= 1) m = fmaxf(m, __shfl_xor(m, o));
                const unsigned long long bal = __ballot(v == m); const unsigned half = (unsigned)(bal >> (32 * hi)); const int idx = (int)__builtin_ctz(half) & 31;
                vals[k] = m; ids[k] = idx; if (r32 == idx) v = -3.0e38f; }
            const float e1 = __expf(vals[1] - vals[0]), e2 = __expf(vals[2] - vals[0]), e3 = __expf(vals[3] - vals[0]); const float inv = 1.0f / (1.0f + e1 + e2 + e3);
            if (r32 < 4) { const int myid = r32 == 0 ? ids[0] : r32 == 1 ? ids[1] : r32 == 2 ? ids[2] : ids[3];
                const float myw = (r32 == 0 ? 1.0f : r32 == 1 ? e1 : r32 == 2 ? e2 : e3) * inv;
                const int rank = __hip_atomic_fetch_add(&hist[myid], 1, __ATOMIC_RELAXED, __HIP_MEMORY_SCOPE_WORKGROUP);
                selE[row * 4 + r32] = myid; selR[row * 4 + r32] = rank; selW[row * 4 + r32] = myw; }
            if (r32 == 0) rstd_l[row] = rstd; }
        __syncthreads();
        if (F.tid < 32) basee[F.tid] = (int)__hip_atomic_fetch_add(ctl + CW_CNT + 64 * F.tid, (unsigned)hist[F.tid], __ATOMIC_RELAXED, __HIP_MEMORY_SCOPE_AGENT);
        __syncthreads();
        if (F.tid < 128) { const int row = F.tid >> 2; const int e = selE[F.tid]; const int pos = basee[e] + selR[F.tid]; const int tok = tok0 + row;
            LIST[e * 8192 + pos] = tok; TOKE[tok * 4 + (F.tid & 3)] = e; TOKP[tok * 4 + (F.tid & 3)] = pos; TOKW[tok * 4 + (F.tid & 3)] = selW[F.tid]; }
        const float* mrow = mod + (size_t)b * 12288;
        { f32x4 gm[8], shv[8], xa[8], xb[8];
          { f32x4 scv[8];
#pragma unroll
            for (int j = 0; j < 8; ++j) { const int k = 4 * F.lane + 256 * j; gm[j] = *(const f32x4*)(a.in[I_GN2] + k); scv[j] = *(const f32x4*)(mrow + 8192 + k); shv[j] = *(const f32x4*)(mrow + 6144 + k); }
#pragma unroll
            for (int j = 0; j < 8; ++j) gm[j] = gm[j] * (scv[j] + 1.0f); }
#pragma unroll 1
          for (int pr = 0; pr < 2; ++pr) { const int rowa = 4 * F.wave + 2 * pr, toka = tok0 + rowa; const float rsa = rstd_l[rowa], rsb = rstd_l[rowa + 1];
#pragma unroll
            for (int j = 0; j < 8; ++j) { const int k = 4 * F.lane + 256 * j; xa[j] = *(const f32x4*)(X1 + (size_t)toka * DM + k); xb[j] = *(const f32x4*)(X1 + (size_t)(toka + 1) * DM + k); }
            __builtin_amdgcn_sched_barrier(0);
#pragma unroll
            for (int j = 0; j < 8; ++j) { const int k = 4 * F.lane + 256 * j;
                const f32x4 ha = xa[j] * rsa * gm[j] + shv[j], hb = xb[j] * rsb * gm[j] + shv[j];
                int wa = 0, wb = 0; wa = __builtin_amdgcn_cvt_pk_fp8_f32(ha.x, ha.y, wa, false); wa = __builtin_amdgcn_cvt_pk_fp8_f32(ha.z, ha.w, wa, true);
                wb = __builtin_amdgcn_cvt_pk_fp8_f32(hb.x, hb.y, wb, false); wb = __builtin_amdgcn_cvt_pk_fp8_f32(hb.z, hb.w, wb, true);
                *(int*)(H2 + (size_t)toka * DM + k) = wa; *(int*)(H2 + (size_t)(toka + 1) * DM + k) = wb; } } }
    }
    __syncthreads();
}

__device__ __forceinline__ void build_etab(Frame& F) {
    unsigned* ctl = (unsigned*)(F.ws + WS_CTL); LAS int* et = (LAS int*)(F.lds + ETAB_OFF);
    __syncthreads();
    if (F.wave == 0) { const int e = F.lane & 31; const int cnt = (int)__hip_atomic_load(ctl + CW_CNT + 64 * e, __ATOMIC_RELAXED, __HIP_MEMORY_SCOPE_AGENT); const int tiles = (cnt + 255) >> 8;
        int incl = tiles;
#pragma unroll
        for (int o = 1; o < 32; o <<= 1) { const int t = __shfl_up(incl, o); if (e >= o) incl += t; }
        const unsigned long long nzm = __ballot(tiles > 0 && F.lane < 32);
        if (F.lane < 32) { et[e] = cnt; et[32 + e] = tiles; et[64 + e] = incl - tiles; if (e == 31) et[64 + 32] = incl;
            const int rk = __builtin_popcountll(nzm & ((1ull << e) - 1ull)); et[128 + e] = rk; if (tiles > 0) et[160 + rk] = e; if (e == 0) et[192] = __builtin_popcountll(nzm); } }
    __syncthreads();
}
__device__ __forceinline__ void cvt_w2_item(const Args& a, unsigned char* ws, int g, int lane) {
    const int e = g >> 10, it = g & 1023;
    cvt_item8<false>(a.in[I_W2] + (size_t)e * 2048 * 2048, 2048, ws + WS_W2T + (size_t)e * 2048 * 2048, it >> 6, 32 * (it & 63), lane);
}
__device__ __forceinline__ void moe_converter(const Args& a, Frame& F, int cw, int ncw, int w2_done) {
    LAS const int* et = (LAS const int*)(F.lds + ETAB_OFF); LAS int* xt = (LAS int*)F.lds;
    unsigned* ctl = (unsigned*)(F.ws + WS_CTL);
    if (F.wave == 0) {
        const int x = F.lane & 7; const int nunits = et[64 + 32] * 16; const int q = nunits / 8, r = nunits % 8;
        const int start = x < r ? x * (q + 1) : r * (q + 1) + (x - r) * q, len = x < r ? q + 1 : q;
        int dlo = 0, dhi = -1;
        if (len > 0) {
#pragma unroll 1
            for (int which = 0; which < 2; ++which) { const int wg = which ? start + len - 1 : start; int e = 0;
                for (int ee = 0; ee < 32; ++ee) if (et[32 + ee] > 0 && et[64 + ee] * 16 <= wg) e = ee;
                const int d = et[128 + e] * 16 + (wg - et[64 + e] * 16) / et[32 + e]; if (which) dhi = d; else dlo = d; } }
        const int dlo_next = __shfl(dlo, (F.lane + 1) & 63), len_next = __shfl(len, (F.lane + 1) & 63);
        if (x < 7 && len > 0 && len_next > 0 && dhi == dlo_next) dhi -= 1;
        const int n = dhi - dlo + 1 > 0 ? dhi - dlo + 1 : 0; int mx = n;
#pragma unroll
        for (int o = 1; o < 8; o <<= 1) mx = max(mx, __shfl_xor(mx, o));
        if (F.lane < 8) { xt[x] = dlo; xt[8 + x] = n; if (x == 0) xt[16] = mx; } }
    __syncthreads();
    const int rmax = __builtin_amdgcn_readfirstlane(xt[16]);
    for (int g = cw; g < rmax * 8 * 128; g += ncw) {
        const int t = g >> 7, sub = g & 127, x = t & 7, r = t >> 3;
        if (r >= __builtin_amdgcn_readfirstlane(xt[8 + x])) continue;
        const int d = __builtin_amdgcn_readfirstlane(xt[x]) + r, e = __builtin_amdgcn_readfirstlane(et[160 + (d >> 4)]), nt = d & 15, kb = sub >> 3, nbl = sub & 7;
        const int n0 = nbl < 4 ? nt * 128 + 32 * nbl : 2048 + nt * 128 + 32 * (nbl - 4);
        cvt_item8<true>(a.in[I_W1] + (size_t)e * 2048 * 4096, 4096, F.ws + WS_W1T + (size_t)e * 4096 * 2048, kb, n0, F.lane);
        asm volatile("s_waitcnt vmcnt(0)" ::: "memory");
        if (F.lane == 0) __hip_atomic_fetch_add(ctl + CW_FLAG + 64 * (e * 16 + nt), 1u, __ATOMIC_RELAXED, __HIP_MEMORY_SCOPE_AGENT);
    }
    for (int g = w2_done + cw; g < 32 * 16 * 64; g += ncw) cvt_w2_item(a, F.ws, g, F.lane);
}

__device__ __forceinline__ void p11_phase(const Args& a, Frame& F) {
    const float* X1 = (const float*)(F.ws + WS_X1); const float* mod = (const float*)(F.ws + WS_MOD); const bf16_t* YB = (const bf16_t*)(F.ws + WS_YB);
    const int* TOKE = (const int*)(F.ws + WS_TOKE); const int* TOKP = (const int*)(F.ws + WS_TOKP); const float* TOKW = (const float*)(F.ws + WS_TOKW);
    LAS const int* et = (LAS const int*)(F.lds + ETAB_OFF);
    build_etab(F);
    const int gw = F.vcu * NWAVES + F.wave, NGW = F.G * NWAVES;
    for (int tok = gw; tok < NLAT; tok += NGW) {
        const int b = tok >> 12; const float* gt2 = mod + (size_t)b * 12288 + 10240;
        const bf16_t* yr[4]; float w[4];
#pragma unroll
        for (int k = 0; k < 4; ++k) { const int e = TOKE[tok * 4 + k]; const int prow = et[64 + e] * 256 + TOKP[tok * 4 + k]; yr[k] = YB_FP8 ? (const bf16_t*)((const unsigned char*)YB + (size_t)prow * DM) : YB + (size_t)prow * DM; w[k] = TOKW[tok * 4 + k]; }
        f32x4 x2[8], gv[8]; u32x2 yv[4][8]; float ss = 0.f;
#pragma unroll
        for (int j = 0; j < 8; ++j) { const int kk = 4 * F.lane + 256 * j;
#pragma unroll
#if YB_FP8
            for (int k = 0; k < 4; ++k) { yv[k][j].x = *(const unsigned*)((const unsigned char*)yr[k] + kk); yv[k][j].y = 0u; }
#else
            for (int k = 0; k < 4; ++k) yv[k][j] = *(const u32x2*)(yr[k] + kk);
#endif
            x2[j] = *(const f32x4*)(X1 + (size_t)tok * DM + kk); gv[j] = *(const f32x4*)(gt2 + kk); }
        __builtin_amdgcn_sched_barrier(0);
#pragma unroll
        for (int j = 0; j < 8; ++j) { f32x4 s = {0.f, 0.f, 0.f, 0.f};
#pragma unroll
#if YB_FP8
            for (int k = 0; k < 4; ++k) { const unsigned y = yv[k][j].x; const f32x2 lo = __builtin_amdgcn_cvt_pk_f32_fp8((int)y, false), hi2 = __builtin_amdgcn_cvt_pk_f32_fp8((int)y, true);
                s.x += w[k] * lo.x; s.y += w[k] * lo.y; s.z += w[k] * hi2.x; s.w += w[k] * hi2.y; }
#else
            for (int k = 0; k < 4; ++k) { const u32x2 y = yv[k][j]; s.x += w[k] * bflo(y.x); s.y += w[k] * bfhi(y.x); s.z += w[k] * bflo(y.y); s.w += w[k] * bfhi(y.y); }
#endif
            x2[j] = x2[j] + gv[j] * s;
            ss += (x2[j].x * x2[j].x + x2[j].y * x2[j].y) + (x2[j].z * x2[j].z + x2[j].w * x2[j].w); }
        const float rstd = 1.0f / sqrtf(wave_sum(ss) * (1.0f / DM) + EPS);
#pragma unroll
        for (int j = 0; j < 8; ++j) { const int kk = 4 * F.lane + 256 * j; *(f32x4*)(a.out + (size_t)tok * DM + kk) = x2[j] * rstd * *(const f32x4*)(a.in[I_GF] + kk); }
    }
}

constexpr int NPHASE = 12;
#ifndef DUP_PHASE
#define DUP_PHASE -1
#endif
#if ATTN_PROJ8
constexpr int W2_TAILA_Q = 56;
__device__ __forceinline__ int w2_tailA_first_idle(int G) { return G == 256 ? 204 : G; }
__device__ __forceinline__ int w2_tail_first_idle(int G) { return G == 256 ? 186 : G; }
__device__ __forceinline__ int w2_tailA_done(int G) { return (G - w2_tailA_first_idle(G)) * W2_TAILA_Q; }
__device__ __forceinline__ int w2_tail_done2(int G) { return w2_tailA_done(G) + (G - w2_tail_first_idle(G)) * W2_TAIL_Q; }
__device__ __forceinline__ int w2_tail_done(int G) { return w2_tail_done2(G) + G * W2_P5_Q; }
#else
__device__ __forceinline__ int w2_tail_first_idle(int G) { const int n3 = 646 - 2 * G; return (n3 > 0 && n3 < G) ? n3 : G; }
__device__ __forceinline__ int w2_tailA_done(int G) { return 0; }
__device__ __forceinline__ int w2_tail_done2(int G) { return (G - w2_tail_first_idle(G)) * W2_TAIL_Q; }
__device__ __forceinline__ int w2_tail_done(int G) { return w2_tail_done2(G) + G * W2_P5_Q; }
#endif
template <int PH> __device__ __forceinline__ void run_phase(const Args& args, Frame& F) {
    { int t_ = threadIdx.x; asm volatile("" : "+v"(t_)); F.tid = t_; F.lane = t_ & 63; }
    if constexpr (PH == 0) p0_phase(args, F);
    if constexpr (PH == 1) p1_phase(args, F);
    if constexpr (PH == 2) {
#if INPROJ_FP8 || PROJ_FP8
        gx::PlainSched S; S.init(F.ws + WS_H, F.ws + WS_WINT, MROWS, PW + 256, DM, F.G, (int)blockIdx.x);
        __syncthreads(); S.build_tables(F.lds); __syncthreads();
        gx::EpiInProj E{(bf16_t*)(F.ws + WS_P), (float*)(F.ws + WS_GATE), args.in[I_BIN], 1.0f / 64.0f};
        gx::gemm_run<gx::EpiInProj, gx::PlainSched, true>(F.lds, S, E, DM / 128, DM / 2, DM);
#else
#if ATTN_PROJ8
        {
            gx::PlainSched S8; S8.init(F.ws + WS_H8, F.ws + WS_WIN8, MROWS, 1536, DM, F.G, (int)blockIdx.x);
            __syncthreads(); S8.build_tables(F.lds); __syncthreads();
            gx::EpiInProj E8{(bf16_t*)(F.ws + WS_P), (float*)(F.ws + WS_GATE), args.in[I_BIN], 1.0f / 64.0f};
            gx::gemm_run<gx::EpiInProj, gx::PlainSched, true>(F.lds, S8, E8, DM / 128, DM / 2, DM);
            const int fa = w2_tailA_first_idle(F.G); const int bx = (int)blockIdx.x;
            if (bx >= fa) { const int base = (bx - fa) * W2_TAILA_Q; for (int q = F.wave; q < W2_TAILA_Q; q += NWAVES) cvt_w2_item(args, F.ws, base + q, F.lane); }
        }
        gx::PlainSched S; S.init(F.ws + WS_H, F.ws + WS_WINT + (size_t)1536 * DM * 2, MROWS, PW + 256 - 1536, DM * 2, F.G, (int)blockIdx.x); S.pn_off = 6;
#else
        gx::PlainSched S; S.init(F.ws + WS_H, F.ws + WS_WINT, MROWS, PW + 256, DM * 2, F.G, (int)blockIdx.x);
#endif
        __syncthreads(); S.build_tables(F.lds); __syncthreads();
        gx::EpiInProj E{(bf16_t*)(F.ws + WS_P), (float*)(F.ws + WS_GATE), args.in[I_BIN], 1.0f};
        gx::gemm_run(F.lds, S, E, DM / 64, DM, DM * 2);
#endif
        { const int fi = w2_tail_first_idle(F.G); const int bx = (int)blockIdx.x;
          if (bx >= fi) { const int base = w2_tailA_done(F.G) + (bx - fi) * W2_TAIL_Q; for (int q = F.wave; q < W2_TAIL_Q; q += NWAVES) cvt_w2_item(args, F.ws, base + q, F.lane); } }
    }
    if constexpr (PH == 3) { p3_phase(args, F); p4_phase(args, F); }
    if constexpr (PH == 4) { }
    if constexpr (PH == 5) { p5_phase(args, F);
        const int base = w2_tail_done2(F.G) + F.vcu * W2_P5_Q; for (int q = F.wave; q < W2_P5_Q; q += NWAVES) cvt_w2_item(args, F.ws, base + q, F.lane); }
    if constexpr (PH == 6) {
#ifndef NO_ATT
        p6_attention(args, F);
#endif
#ifndef NO_MOUT
        p6_mlstm_out(args, F);
#endif
    }
    if constexpr (PH == 7) {
#if PROJ_FP8
        gx::PlainSched S; S.init(F.ws + WS_Y, F.ws + WS_WOUTT, NLAT, DM, DM, F.G, (int)blockIdx.x);
        __syncthreads(); S.build_tables(F.lds); __syncthreads();
        gx::EpiOutProj E{args.in[I_X], (float*)(F.ws + WS_X1), (const float*)(F.ws + WS_MOD), 1.0f / 64.0f};
        gx::gemm_run<gx::EpiOutProj, gx::PlainSched, true>(F.lds, S, E, DM / 128, DM / 2, DM);
#else
        gx::PlainSched S; S.init(F.ws + WS_Y, F.ws + WS_WOUTT, NLAT, DM, DM * 2, F.G, (int)blockIdx.x);
        __syncthreads(); S.build_tables(F.lds); __syncthreads();
        gx::EpiOutProj E{args.in[I_X], (float*)(F.ws + WS_X1), (const float*)(F.ws + WS_MOD), 1.0f};
        gx::gemm_run(F.lds, S, E, DM / 64, DM, DM * 2);
#endif
    }
    if constexpr (PH == 8) p8_phase(args, F);
    if constexpr (PH == 9) {
        build_etab(F);
        unsigned* ctl9 = (unsigned*)(F.ws + WS_CTL);
        int cpx = 0; const int n8 = F.G / 8;
        if (F.G == 256) { const int nun = __builtin_amdgcn_readfirstlane(((LAS const int*)(F.lds + ETAB_OFF))[64 + 32]) * 16; float best = 3.0e38f;
#pragma unroll
            for (int c = CPX - 2; c <= CPX + 2; ++c) { const int gq = (32 - c) * 8; const float tg = 27.5f * (float)((nun + gq - 1) / gq), tc = 424.0f * 14.0f / (float)c, tm = tg > tc ? tg : tc;
                if (tm < best) { best = tm; cpx = c; } } }
        else cpx = (F.G % 8 == 0 && n8 > CPX) ? CPX : 0;
        const int xl = (int)blockIdx.x & 7, jx = (int)blockIdx.x >> 3;
        if (cpx > 0 && jx < cpx) moe_converter(args, F, (jx * 8 + xl) * NWAVES + F.wave, cpx * 8 * NWAVES, w2_tail_done(F.G));
        else {
            gx::MoeSched<16, true> S;
            if (cpx > 0) S.init(F.ws + WS_H, F.ws + WS_W1T, F.lds, (n8 - cpx) * 8, (jx - cpx) * 8 + xl, (const int*)(F.ws + WS_LIST), ctl9 + CW_FLAG, ctl9 + CW_TMO);
            else {
                for (int g = (int)blockIdx.x * NWAVES + F.wave; g < 32 * 16 * 128; g += F.G * NWAVES) { const int e = g >> 11, it = g & 2047; cvt_item8<false>(args.in[I_W1] + (size_t)e * 2048 * 4096, 4096, F.ws + WS_W1T + (size_t)e * 4096 * 2048, it >> 7, 32 * (it & 127), F.lane); }
                for (int g = (int)blockIdx.x * NWAVES + F.wave; g < 32 * 16 * 64; g += F.G * NWAVES) { const int e = g >> 10, it = g & 1023; cvt_item8<false>(args.in[I_W2] + (size_t)e * 2048 * 2048, 2048, F.ws + WS_W2T + (size_t)e * 2048 * 2048, it >> 6, 32 * (it & 63), F.lane); }
                S.init(F.ws + WS_H, F.ws + WS_W1T, F.lds, F.G, (int)blockIdx.x, (const int*)(F.ws + WS_LIST)); }
            S.build_tables(F.lds); __syncthreads();
            gx::EpiMoe1 E{F.ws + WS_ACT, args.in[I_B1], 1.0f / 64.0f};
            gx::gemm_run<gx::EpiMoe1, gx::MoeSched<16, true>, true>(F.lds, S, E, DM / 128, DM / 2, DM);
        }
    }
    if constexpr (PH == 10) {
        build_etab(F);
        gx::MoeSched<8, false> S; S.init(F.ws + WS_ACT, F.ws + WS_W2T, F.lds, F.G, (int)blockIdx.x, nullptr);
        S.build_tables(F.lds); __syncthreads();
#if YB_FP8
        gx::EpiF8Bias E{F.ws + WS_YB, DM, args.in[I_B2], DM, 1.0f / 64.0f};
        gx::gemm_run<gx::EpiF8Bias, gx::MoeSched<8, false>, true>(F.lds, S, E, DFF / 128, DFF / 2, DFF);
#else
        gx::EpiBf16Bias E{(bf16_t*)(F.ws + WS_YB), DM, args.in[I_B2], DM, 1.0f / 64.0f};
        gx::gemm_run<gx::EpiBf16Bias, gx::MoeSched<8, false>, true>(F.lds, S, E, DFF / 128, DFF / 2, DFF);
#endif
    }
    if constexpr (PH == 11) p11_phase(args, F);
}
__global__ void __launch_bounds__(NTHR, 2) mk_fwd(Args args) {
    extern __shared__ __attribute__((aligned(16))) unsigned char lds[];
    Frame F;
    F.lds = (LAS unsigned char*)lds; F.ldsg = (char*)lds;
    F.tid = threadIdx.x; F.lane = F.tid & 63; F.wave = __builtin_amdgcn_readfirstlane(F.tid >> 6);
    F.G = gridDim.x; { const int bx = blockIdx.x; F.vcu = (F.G % 8 == 0) ? (bx % 8) * (F.G / 8) + bx / 8 : bx; }
    F.ws = args.ws;
    volatile LAS unsigned* MISC = (volatile LAS unsigned*)(F.lds + MISC_OFF);
    if (F.tid < 64) MISC[F.tid] = 0u;
    __syncthreads();
    unsigned* ctl = (unsigned*)(F.ws + WS_CTL);
    XcdBarrier bar; bar.bar = ctl + CW_BAR; bar.x = 0; bar.st = nullptr;
    const int lo = args.ph_lo, hi = args.ph_hi;
    if (hi - lo > 1) bar = xcd_barrier_post(ctl + CW_BAR, MISC + 8);
#ifndef ONLY_PHASE
#define ONLY_PHASE -1
#endif
#define IN(k) ((ONLY_PHASE < 0 || ONLY_PHASE == (k)) && lo <= (k) && (k) < hi)
#ifndef TIME_PHASE
#define TIME_PHASE -1
#endif
#define DO_PHASE(k) do { if (TIME_PHASE == (k) && blockIdx.x == 0 && F.tid == 0) { const unsigned long long t_ = __builtin_amdgcn_s_memrealtime(); MISC[16] = (unsigned)t_; } \
                         if (IN(k)) { run_phase<k>(args, F); if (DUP_PHASE == (k)) { xcd_barrier(bar); run_phase<k>(args, F); } } \
                         if (IN(k) && IN((k) + 1)) xcd_barrier(bar); \
                         if (TIME_PHASE == (k) && blockIdx.x == 0 && threadIdx.x == 0) { const unsigned long long t_ = __builtin_amdgcn_s_memrealtime(); MISC[17] = (unsigned)t_ - MISC[16]; } } while (0)
    DO_PHASE(0); DO_PHASE(1); DO_PHASE(2); DO_PHASE(3);   DO_PHASE(5);
    DO_PHASE(6); DO_PHASE(7); DO_PHASE(8); DO_PHASE(9); DO_PHASE(10); DO_PHASE(11);
    if (TIME_PHASE >= 0 && blockIdx.x == 0 && threadIdx.x == 0) { const unsigned dt = MISC[17]; const unsigned long long t0_ = __builtin_amdgcn_s_memrealtime();
        while ((unsigned)(__builtin_amdgcn_s_memrealtime() - t0_) < 4u * dt) __builtin_amdgcn_s_sleep(8); }
#undef IN
#undef DO_PHASE
}

extern "C" void kernel_launch(void* const* d_in, const int* in_sizes, int n_in, void* d_out, int out_size, void* d_ws, size_t ws_size, hipStream_t stream) {
    static int grid = 0;
    if (grid == 0) {
        if (n_in != 21 || out_size != NLAT * DM || ws_size < WS_END) { fprintf(stderr, "kernel_launch: unexpected shapes (n_in %d out %d ws %zu)\n", n_in, out_size, ws_size); grid = -1; return; }
        int dev = 0, cus = 0, per_cu = 0;
        if (hipGetDevice(&dev) != hipSuccess || hipDeviceGetAttribute(&cus, hipDeviceAttributeMultiprocessorCount, dev) != hipSuccess) { grid = -1; return; }
        if (hipFuncSetAttribute((const void*)mk_fwd, hipFuncAttributeMaxDynamicSharedMemorySize, LDS_BYTES) != hipSuccess) { fprintf(stderr, "kernel_launch: hipFuncSetAttribute failed\n"); grid = -1; return; }
        if (hipOccupancyMaxActiveBlocksPerMultiprocessor(&per_cu, (const void*)mk_fwd, NTHR, LDS_BYTES) != hipSuccess || per_cu < 1) { fprintf(stderr, "kernel_launch: occupancy query says %d blocks per CU\n", per_cu); (void)hipGetLastError(); grid = -1; return; }
        grid = cus;
    }
    if (grid < 0) return;
    (void)hipMemsetAsync((char*)d_ws + WS_CTL, 0, CTL_ZERO_BYTES, stream);
    Args a{};
    for (int i = 0; i < 21; ++i) a.in[i] = (const float*)d_in[i];
    a.out = (float*)d_out; a.ws = (unsigned char*)d_ws;
#if MK_ONE_LAUNCH
    a.ph_lo = 0; a.ph_hi = NPHASE;
    hipLaunchKernelGGL(mk_fwd, dim3(grid), dim3(NTHR), LDS_BYTES, stream, a);
#else
    for (int p = 0; p < NPHASE; ++p) { a.ph_lo = p; a.ph_hi = p + 1; hipLaunchKernelGGL(mk_fwd, dim3(grid), dim3(NTHR), LDS_BYTES, stream, a); }
#endif
    const hipError_t le = hipPeekAtLastError();
    if (le != hipSuccess) fprintf(stderr, "kernel_launch: launch failed: %s\n", hipGetErrorName(le));
}
```

```cpp
#include <hip/hip_runtime.h>
#include <cstdio>
#include <cstdint>

#ifndef MK_ONE_LAUNCH
#define MK_ONE_LAUNCH 1
#endif
#ifndef INPROJ_FP8
#define INPROJ_FP8 0
#endif
#ifndef ATT_PV8
#define ATT_PV8 1
#endif
#ifndef YB_FP8
#define YB_FP8 1
#endif
#ifndef ATTN_PROJ8
#define ATTN_PROJ8 1
#endif
#ifndef ATT_QK8
#define ATT_QK8 1
#endif
#ifndef PROJ_FP8
#define PROJ_FP8 0
#endif

#define LAS __attribute__((address_space(3)))
#define GAS __attribute__((address_space(1)))
typedef unsigned short bf16_t;
typedef short bf16x8 __attribute__((ext_vector_type(8)));
typedef short s16x4 __attribute__((ext_vector_type(4)));
typedef float f32x2 __attribute__((ext_vector_type(2)));
typedef float f32x4 __attribute__((ext_vector_type(4)));
typedef float f32x16 __attribute__((ext_vector_type(16)));
typedef unsigned u32x2 __attribute__((ext_vector_type(2)));
typedef unsigned u32x4 __attribute__((ext_vector_type(4)));
typedef GAS unsigned gu32;

constexpr int DM = 2048, NB = 2, SEQ = 4096, CTXL = 256, ROWS_B = SEQ + CTXL  , MROWS = NB * ROWS_B  , NLAT = NB * SEQ  ;
constexpr int GRID_W = 64;
constexpr float EPS = 1e-6f;
constexpr int NH = 8, KVH = 2, HD = 128;
constexpr int MH = 4, MDK = 128, MDV = 256, MCH = 128;
constexpr int IN_COLS = 4624, PW = 4608;
constexpr int C_Q = 0, C_K = 1024, C_V = 1280, C_MQ = 1536, C_MK = 2048, C_MV = 2560, C_MO = 3584, C_G = 4608;
constexpr int NEXP = 32, TOPK = 4, DFF = 2048;
constexpr int NTB = ROWS_B / MCH;
constexpr int NCHAIN = NB * 2 * MH;
constexpr int MAXTILES = 160;

constexpr size_t MiB = 1u << 20;
constexpr size_t WS_CTL = 0, CTL_ZERO_BYTES = 1 * MiB;
constexpr size_t WS_MOD = 1 * MiB;
constexpr size_t WS_WRS = 2 * MiB;
constexpr size_t WS_GATE = 3 * MiB;
constexpr size_t WS_GA = 4 * MiB;
constexpr size_t WS_GM = WS_GA + 512 * 1024;
constexpr size_t WS_GB = WS_GM + 512 * 1024;
constexpr size_t WS_GC = WS_GB + 512 * 1024;
constexpr size_t WS_TOKE = 6 * MiB;
constexpr size_t WS_TOKP = WS_TOKE + 128 * 1024;
constexpr size_t WS_TOKW = WS_TOKP + 128 * 1024;
constexpr size_t WS_LIST = 7 * MiB;
constexpr size_t WS_NL = 8 * MiB;
constexpr size_t WS_NST = 9 * MiB;
constexpr size_t WS_WINT = 16 * MiB;
constexpr size_t WS_WOUTT = 36 * MiB;
constexpr size_t WS_H = 48 * MiB;
constexpr size_t WS_P = 96 * MiB;
constexpr size_t WS_Y = 184 * MiB;
constexpr size_t WS_X1 = 224 * MiB;
constexpr size_t WS_LST = 288 * MiB;
constexpr size_t WS_CST = 368 * MiB;
constexpr size_t WS_ACT = 416 * MiB;
constexpr size_t WS_YB = 576 * MiB;
constexpr size_t WS_W1T = 768 * MiB;
constexpr size_t WS_W2T = 1280 * MiB;
constexpr size_t WS_Q8 = 1536 * MiB;
constexpr size_t WS_K8 = 1548 * MiB;
constexpr size_t WS_H8 = 1552 * MiB;
constexpr size_t WS_WIN8 = 1572 * MiB;
constexpr size_t WS_VT8 = 1576 * MiB;
constexpr size_t WS_END = 1580 * MiB;
constexpr int CW_TMO = 0;
constexpr int CW_BAR = 4096;
constexpr int CW_CNT = 8192;
constexpr int CW_FLAG = 16384;
constexpr int CPX = 14;
constexpr int W2_TAIL_Q = 96;
constexpr int W2_P5_Q = 8;

constexpr int RING_BYTES = 131072;
constexpr int TAB_OFF = 131072;
constexpr int NSLOT = 32;
constexpr int ETAB_OFF = TAB_OFF + 16384;
constexpr int MISC_OFF = ETAB_OFF + 1024;
constexpr int LDS_BYTES = MISC_OFF + 256;

__device__ __forceinline__ unsigned cvt_pk_bf16(float lo, float hi) { unsigned r; asm volatile("v_cvt_pk_bf16_f32 %0, %1, %2" : "=v"(r) : "v"(lo), "v"(hi)); return r; }
__device__ __forceinline__ float bf2f(unsigned short b) { return __uint_as_float(((unsigned)b) << 16); }
__device__ __forceinline__ float bflo(unsigned w) { return __uint_as_float(w << 16); }
__device__ __forceinline__ float bfhi(unsigned w) { return __uint_as_float(w & 0xffff0000u); }
__device__ __forceinline__ float wave_sum(float v) {
#pragma unroll
    for (int o = 1; o < 64; o <<= 1) v += __shfl_xor(v, o);
    return v;
}
#define LDS_WAIT() asm volatile("s_waitcnt lgkmcnt(0)" ::: "memory")
#define VM_WAIT() asm volatile("s_waitcnt vmcnt(0)" ::: "memory")

#define XB_TMO      128
#define XB_XCNT(j)  (256  + 64 * (j))
#define XB_XSUB(j)  (1280 + 64 * (j))
#define XB_XGEN(j)  (2304 + 64 * (j))
#define XB_TOP      3328
#define XB_TOPGEN   3392
#define XCD_BAR_WORDS 3456
#define XB_SPIN_CAP (1u << 22)
__device__ __forceinline__ unsigned xb_ld(unsigned* p)              { return __hip_atomic_load(p, __ATOMIC_RELAXED, __HIP_MEMORY_SCOPE_AGENT); }
__device__ __forceinline__ unsigned xb_add(unsigned* p, unsigned v) { return __hip_atomic_fetch_add(p, v, __ATOMIC_RELAXED, __HIP_MEMORY_SCOPE_AGENT); }
__device__ __forceinline__ unsigned xb_xcc_id() { return (unsigned)__builtin_amdgcn_s_getreg((3 << 11) | 20) & 0xFu; }
#define XB_SPIN(cond, bar) do { unsigned _sp = 0; while (cond) { __builtin_amdgcn_s_sleep(1); \
    if ((++_sp & 255u) == 0u) { if (xb_ld(&(bar)[XB_TMO])) break; if (_sp > XB_SPIN_CAP) { atomicAdd(&(bar)[XB_TMO], 1u); break; } } } } while (0)
struct XcdBarrier { unsigned* bar; unsigned x; volatile LAS unsigned* st; };
__device__ __forceinline__ XcdBarrier xcd_barrier_post(unsigned* bar, volatile LAS unsigned* st) {
    XcdBarrier b; b.bar = bar; b.x = xb_xcc_id(); b.st = st;
    if (threadIdx.x == 0) (void)xb_add(&bar[XB_XCNT(b.x)], 1u);
    return b;
}
__device__ __forceinline__ void xcd_barrier_complete(unsigned* bar, unsigned x, unsigned& nloc, unsigned& nx) {
    const unsigned G = gridDim.x * gridDim.y * gridDim.z;
    unsigned sum, cnt, mine, sp = 0u;
    for (;;) {
        sum = 0u; cnt = 0u; mine = 0u;
#pragma unroll
        for (unsigned j = 0; j < 16; ++j) { const unsigned c = xb_ld(&bar[XB_XCNT(j)]); sum += c; cnt += (c > 0u) ? 1u : 0u; mine = (j == x) ? c : mine; }
        if (sum == G) break;
        __builtin_amdgcn_s_sleep(1);
        if ((++sp & 255u) == 0u) { if (xb_ld(&bar[XB_TMO])) break; if (sp > XB_SPIN_CAP) { atomicAdd(&bar[XB_TMO], 1u); break; } }
    }
    nloc = mine > 0u ? mine : 1u; nx = cnt > 0u ? cnt : 1u;
}
__device__ __forceinline__ void xcd_barrier(const XcdBarrier& b) {
    asm volatile("s_waitcnt vmcnt(0)" ::: "memory");
    __syncthreads();
    if (threadIdx.x == 0) {
        unsigned* bar = b.bar;
        __builtin_amdgcn_s_waitcnt(0);
        unsigned nloc = b.st[0], nx = b.st[1];
        if (nloc == 0u) { xcd_barrier_complete(bar, b.x, nloc, nx); b.st[0] = nloc; b.st[1] = nx; }
        const unsigned old = xb_add(&bar[XB_XSUB(b.x)], 1u);
        const unsigned gen = old / nloc;
        if (old + 1u == (gen + 1u) * nloc) {
            __builtin_amdgcn_fence(__ATOMIC_RELEASE, "agent");
            asm volatile("s_waitcnt vmcnt(0)" ::: "memory");
            const unsigned og = xb_add(&bar[XB_TOP], 1u);
            const unsigned tg = og / nx;
            if (og + 1u == (tg + 1u) * nx) xb_add(&bar[XB_TOPGEN], 1u);
            else XB_SPIN(xb_ld(&bar[XB_TOPGEN]) == tg, bar);
            __builtin_amdgcn_fence(__ATOMIC_ACQUIRE, "agent");
            xb_add(&bar[XB_XGEN(b.x)], 1u);
            asm volatile("s_waitcnt vmcnt(0)" ::: "memory");
        } else {
            XB_SPIN(xb_ld(&bar[XB_XGEN(b.x)]) == gen, bar);
            __builtin_amdgcn_fence(__ATOMIC_ACQUIRE, "agent");
            asm volatile("s_waitcnt vmcnt(0)" ::: "memory");
        }
    }
    __syncthreads();
}

namespace gx {
constexpr int BM = 256, BK = 64, HALF = 128, HTB = HALF * BK * 2, STAGE_BYTES = 8 * HTB, NXCD = 8;
__host__ __device__ __forceinline__ int lds_byte(int r, int c) { const int st = (r >> 4) * 2 + (c >> 5), rr = r & 15, cc = c & 31, ob = rr * 64 + cc * 2; return st * 1024 + (ob ^ (((ob >> 9) & 1) << 5)); }
__host__ __device__ __forceinline__ void stage_rc(int b, int& R, int& C) { const int st = b / 1024, sb = b % 1024, swz = sb ^ (((sb >> 9) & 1) << 5); R = (st >> 1) * 16 + swz / 64; C = (st & 1) * 32 + (swz % 64) / 2; }
__host__ __device__ __forceinline__ int perm32(int rho) { const int n = rho >> 4, i = rho & 15; return 8 * (i >> 2) + 4 * n + (i & 3); }

struct Unit { const char* A; const char* B0; const char* B1; int slot, pm, pn, e; };

typedef int i32x8 __attribute__((ext_vector_type(8)));
__device__ __forceinline__ i32x8 cat8(bf16x8 lo, bf16x8 hi) { typedef int i32x4 __attribute__((ext_vector_type(4))); const i32x4 a = __builtin_bit_cast(i32x4, lo), b = __builtin_bit_cast(i32x4, hi); return (i32x8){a.x, a.y, a.z, a.w, b.x, b.y, b.z, b.w}; }
template <class Epi, class Sched, bool FP8 = false>
__device__ __forceinline__ void gemm_run(LAS unsigned char* lds, const Sched& S, const Epi& E, const int nt, const int ldb, const unsigned apitch  ) {
    const int tid = threadIdx.x, wid = __builtin_amdgcn_readfirstlane(tid >> 6), lane = tid & 63, wr = wid >> 2, wc = wid & 3, fr = lane & 15, fq = lane >> 4;
    unsigned voffB[2], colA[2]; int rowA[2];
#pragma unroll
    for (int i = 0; i < 2; ++i) { int R, C; stage_rc(tid * 16 + i * 8192, R, C); const int Rb = Epi::PERM ? ((R & ~31) + perm32(R & 31)) : R;
        voffB[i] = (unsigned)(Rb * ldb + C) * 2u; rowA[i] = R; colA[i] = (unsigned)C * 2u; }
    const LAS unsigned short* tab = (const LAS unsigned short*)(lds + TAB_OFF);
    unsigned vA0[2], vA1[2];
#define GX_LOADTAB(slot) do { _Pragma("unroll") for (int _i = 0; _i < 2; ++_i) { vA0[_i] = (unsigned)tab[(slot) * 256 + rowA[_i]] * apitch + colA[_i]; vA1[_i] = (unsigned)tab[(slot) * 256 + 128 + rowA[_i]] * apitch + colA[_i]; } } while (0)
    const size_t kstep = (size_t)(BK * 2);
    const unsigned ldsw = (unsigned)wid * 1024u;
    const int aoff = lds_byte(wr * 64 + fr, fq * 8), boff = lds_byte(wc * 32 + fr, fq * 8);
#define GX_SA(b, h) (((b) * 2 + (h)) * HTB)
#define GX_SB(b, h) ((4 + (b) * 2 + (h)) * HTB)
#define GX_STAGE(bufoff, gbase, voff) do { _Pragma("unroll") for (int _i = 0; _i < 2; ++_i) \
        __builtin_amdgcn_global_load_lds((const unsigned*)((const char*)(gbase) + (voff)[_i]), (LAS unsigned*)(lds + (bufoff) + ldsw + _i * 8192), 16, 0, 0); } while (0)
#define GX_LDA(dst, b, h) do { _Pragma("unroll") for (int m = 0; m < 4; ++m) _Pragma("unroll") for (int k = 0; k < 2; ++k) dst[m][k] = *(const LAS bf16x8*)(lds + GX_SA(b, h) + aoff + m * 2048 + k * 1024); } while (0)
#define GX_LDB(dst, b, h) do { _Pragma("unroll") for (int n = 0; n < 2; ++n) _Pragma("unroll") for (int k = 0; k < 2; ++k) dst[n][k] = *(const LAS bf16x8*)(lds + GX_SB(b, h) + boff + n * 2048 + k * 1024); } while (0)
#define GX_MMA(ai, bj, At, Bt) do { __builtin_amdgcn_s_setprio(1); _Pragma("unroll") for (int m = 0; m < 4; ++m) _Pragma("unroll") for (int n = 0; n < 2; ++n) { \
        if constexpr (FP8) acc[ai][bj][m][n] = __builtin_amdgcn_mfma_scale_f32_16x16x128_f8f6f4(cat8(Bt[n][0], Bt[n][1]), cat8(At[m][0], At[m][1]), acc[ai][bj][m][n], 0, 0, 0, 0x7f7f7f7f, 0, 0x7f7f7f7f); \
        else { _Pragma("unroll") for (int k = 0; k < 2; ++k) acc[ai][bj][m][n] = __builtin_amdgcn_mfma_f32_16x16x32_bf16(Bt[n][k], At[m][k], acc[ai][bj][m][n], 0, 0, 0); } } \
        __builtin_amdgcn_s_setprio(0); } while (0)
#define GX_WAIT_V(n) asm volatile("s_waitcnt vmcnt(" #n ")" ::: "memory")
#define GX_WAIT_L(n) asm volatile("s_waitcnt lgkmcnt(" #n ")" ::: "memory")
#define GX_BAR __builtin_amdgcn_s_barrier()
#define GX_SCHED __builtin_amdgcn_sched_barrier(0)
    Unit cur, nxt; int ui = 0;
    if (!S.next(0, cur)) return;
    f32x4 acc[2][2][4][2];
#pragma unroll
    for (int a = 0; a < 2; ++a)
#pragma unroll
        for (int b = 0; b < 2; ++b)
#pragma unroll
            for (int m = 0; m < 4; ++m)
#pragma unroll
                for (int n = 0; n < 2; ++n) acc[a][b][m][n] = (f32x4){0.f, 0.f, 0.f, 0.f};
    bf16x8 At[4][2], B0[2][2], B1[2][2];
    const char* cA = cur.A; const char* cB0 = cur.B0; const char* cB1 = cur.B1;
    S.a_ready(cur);
    GX_LOADTAB(cur.slot);
    GX_STAGE(GX_SB(0, 0), cB0, voffB); GX_STAGE(GX_SB(0, 1), cB1, voffB); GX_STAGE(GX_SA(0, 0), cA, vA0); GX_STAGE(GX_SA(0, 1), cA, vA1);
    if (wr == 1) GX_BAR;
    GX_WAIT_V(2); GX_BAR;
    GX_STAGE(GX_SB(1, 0), cB0 + kstep, voffB); GX_STAGE(GX_SA(1, 0), cA + kstep, vA0); GX_STAGE(GX_SB(1, 1), cB1 + kstep, voffB);
    GX_WAIT_V(6); GX_BAR;
    for (;;) {
        const bool has_next = S.next(ui + 1, nxt);
        const char* nA = has_next ? nxt.A : cA; const char* nB0 = has_next ? nxt.B0 : cB0; const char* nB1 = has_next ? nxt.B1 : cB1;
        for (int t = 0; t < nt; t += 2) {
            const bool last = (t == nt - 2);
            const char* a1 = cA + (size_t)(t + 1) * kstep;
            const char* a2 = last ? nA : cA + (size_t)(t + 2) * kstep;
            const char* b20 = last ? nB0 : cB0 + (size_t)(t + 2) * kstep; const char* b21 = last ? nB1 : cB1 + (size_t)(t + 2) * kstep;
            const char* a3 = a2 + kstep; const char* b30 = b20 + kstep; const char* b31 = b21 + kstep;
            if (last && has_next) S.a_ready(nxt);
            GX_LDB(B0, 0, 0); GX_LDB(B1, 0, 1); GX_SCHED; GX_LDA(At, 0, 0); GX_STAGE(GX_SA(1, 1), a1, vA1);
            if (last && has_next) GX_LOADTAB(nxt.slot);
            GX_WAIT_V(8); GX_WAIT_L(0); GX_BAR; GX_MMA(0, 0, At, B0); GX_MMA(0, 1, At, B1); GX_BAR; GX_SCHED;
            GX_LDA(At, 0, 1); GX_STAGE(GX_SB(0, 0), b20, voffB); GX_STAGE(GX_SB(0, 1), b21, voffB); GX_STAGE(GX_SA(0, 0), a2, vA0);
            GX_WAIT_V(8); GX_WAIT_L(0); GX_BAR; GX_MMA(1, 0, At, B0); GX_MMA(1, 1, At, B1); GX_BAR; GX_SCHED;
            GX_LDB(B0, 1, 0); GX_LDB(B1, 1, 1); GX_SCHED; GX_LDA(At, 1, 0); GX_STAGE(GX_SA(0, 1), a2, vA1);
            GX_WAIT_V(8); GX_WAIT_L(0); GX_BAR; GX_MMA(0, 0, At, B0); GX_MMA(0, 1, At, B1); GX_BAR; GX_SCHED;
            GX_LDA(At, 1, 1); GX_STAGE(GX_SB(1, 0), b30, voffB); GX_STAGE(GX_SB(1, 1), b31, voffB); GX_STAGE(GX_SA(1, 0), a3, vA0);
            GX_WAIT_V(8); GX_WAIT_L(0); GX_BAR; GX_MMA(1, 0, At, B0); GX_MMA(1, 1, At, B1); GX_BAR; GX_SCHED;
        }
        if (wr == 0) GX_BAR;
        E(acc, cur, wr, wc, fr, fq);
        if (!has_next) break;
#pragma unroll
        for (int a = 0; a < 2; ++a)
#pragma unroll
            for (int b = 0; b < 2; ++b)
#pragma unroll
                for (int m = 0; m < 4; ++m)
#pragma unroll
                    for (int n = 0; n < 2; ++n) acc[a][b][m][n] = (f32x4){0.f, 0.f, 0.f, 0.f};
        cur = nxt; cA = nA; cB0 = nB0; cB1 = nB1; ++ui;
        if (wr == 1) GX_BAR;
    }
    GX_WAIT_V(0);
    GX_BAR;
#undef GX_LOADTAB
#undef GX_SA
#undef GX_SB
#undef GX_STAGE
#undef GX_LDA
#undef GX_LDB
#undef GX_MMA
#undef GX_WAIT_V
#undef GX_WAIT_L
#undef GX_BAR
#undef GX_SCHED
}

struct EpiBf16Bias {
    static constexpr bool PERM = true;
    bf16_t* O; int ldc; const float* bias; int bias_estride; float ascale;
    __device__ __forceinline__ void operator()(const f32x4 (&acc)[2][2][4][2], const Unit& u, int wr, int wc, int fr, int fq) const {
        const int row0 = u.pm * BM + wr * 64 + fr, col0 = u.pn * BM + wc * 32 + 8 * fq;
        const float* bp = bias + (size_t)u.e * bias_estride + col0;
        f32x4 bv[2][2];
#pragma unroll
        for (int bj = 0; bj < 2; ++bj)
#pragma unroll
            for (int n = 0; n < 2; ++n) bv[bj][n] = *(const f32x4*)(bp + bj * HALF + 4 * n);
#pragma unroll
        for (int ai = 0; ai < 2; ++ai)
#pragma unroll
            for (int m = 0; m < 4; ++m) { bf16_t* rowp = O + (size_t)(row0 + ai * HALF + m * 16) * ldc + col0;
#pragma unroll
                for (int bj = 0; bj < 2; ++bj) { const f32x4 v0 = acc[ai][bj][m][0] * ascale + bv[bj][0], v1 = acc[ai][bj][m][1] * ascale + bv[bj][1];
                    u32x4 w; w.x = cvt_pk_bf16(v0[0], v0[1]); w.y = cvt_pk_bf16(v0[2], v0[3]); w.z = cvt_pk_bf16(v1[0], v1[1]); w.w = cvt_pk_bf16(v1[2], v1[3]);
                    *(u32x4*)(rowp + bj * HALF) = w; } }
    }
};
struct EpiF8Bias {
    static constexpr bool PERM = true;
    unsigned char* O; int ldc; const float* bias; int bias_estride; float ascale;
    __device__ __forceinline__ void operator()(const f32x4 (&acc)[2][2][4][2], const Unit& u, int wr, int wc, int fr, int fq) const {
        const int row0 = u.pm * BM + wr * 64 + fr, col0 = u.pn * BM + wc * 32 + 8 * fq;
        const float* bp = bias + (size_t)u.e * bias_estride + col0;
        f32x4 bv[2][2];
#pragma unroll
        for (int bj = 0; bj < 2; ++bj)
#pragma unroll
            for (int n = 0; n < 2; ++n) bv[bj][n] = *(const f32x4*)(bp + bj * HALF + 4 * n);
#pragma unroll
        for (int ai = 0; ai < 2; ++ai)
#pragma unroll
            for (int m = 0; m < 4; ++m) { unsigned char* rowp = O + (size_t)(row0 + ai * HALF + m * 16) * ldc + col0;
#pragma unroll
                for (int bj = 0; bj < 2; ++bj) { const f32x4 v0 = acc[ai][bj][m][0] * ascale + bv[bj][0], v1 = acc[ai][bj][m][1] * ascale + bv[bj][1];
                    int w0 = 0, w1 = 0; w0 = __builtin_amdgcn_cvt_pk_fp8_f32(v0[0], v0[1], w0, false); w0 = __builtin_amdgcn_cvt_pk_fp8_f32(v0[2], v0[3], w0, true);
                    w1 = __builtin_amdgcn_cvt_pk_fp8_f32(v1[0], v1[1], w1, false); w1 = __builtin_amdgcn_cvt_pk_fp8_f32(v1[2], v1[3], w1, true);
                    *(u32x2*)(rowp + bj * HALF) = (u32x2){(unsigned)w0, (unsigned)w1}; } }
    }
};
struct EpiInProj {
    static constexpr bool PERM = true;
    bf16_t* O; float* gate; const float* bias; float ascale;
    __device__ __forceinline__ void operator()(const f32x4 (&acc)[2][2][4][2], const Unit& u, int wr, int wc, int fr, int fq) const {
        if (u.pn < 18) { EpiBf16Bias E{O, PW, bias, 0, ascale}; E(acc, u, wr, wc, fr, fq); return; }
        if (wc == 0 && fq < 2) { const int row0 = u.pm * BM + wr * 64 + fr; const float* bp = bias + C_G + 8 * fq;
            const f32x4 b0 = *(const f32x4*)bp, b1 = *(const f32x4*)(bp + 4);
#pragma unroll
            for (int ai = 0; ai < 2; ++ai)
#pragma unroll
                for (int m = 0; m < 4; ++m) { float* gp = gate + (size_t)(row0 + ai * HALF + m * 16) * 16 + 8 * fq;
                    *(f32x4*)gp = acc[ai][0][m][0] * ascale + b0; *(f32x4*)(gp + 4) = acc[ai][0][m][1] * ascale + b1; } }
    }
};
struct EpiOutProj {
    static constexpr bool PERM = false;
    const float* x; float* x1; const float* mod; float ascale;
    __device__ __forceinline__ void operator()(const f32x4 (&acc)[2][2][4][2], const Unit& u, int wr, int wc, int fr, int fq) const {
        const int row0 = u.pm * BM + wr * 64 + fr, col0 = u.pn * BM + wc * 32 + 4 * fq;
        const int b = u.pm >> 4;
        const float* gp = mod + (size_t)b * 12288 + 4096 + col0;
        f32x4 gv[2][2];
#pragma unroll
        for (int bj = 0; bj < 2; ++bj)
#pragma unroll
            for (int n = 0; n < 2; ++n) gv[bj][n] = *(const f32x4*)(gp + bj * HALF + n * 16) * ascale;
#pragma unroll
        for (int ai = 0; ai < 2; ++ai) { f32x4 xv[4][2][2];
#pragma unroll
            for (int m = 0; m < 4; ++m) { const size_t off = (size_t)(row0 + ai * HALF + m * 16) * DM + col0;
#pragma unroll
                for (int bj = 0; bj < 2; ++bj)
#pragma unroll
                    for (int n = 0; n < 2; ++n) xv[m][bj][n] = *(const f32x4*)(x + off + bj * HALF + n * 16); }
            __builtin_amdgcn_sched_barrier(0);
#pragma unroll
            for (int m = 0; m < 4; ++m) { const size_t off = (size_t)(row0 + ai * HALF + m * 16) * DM + col0;
#pragma unroll
                for (int bj = 0; bj < 2; ++bj)
#pragma unroll
                    for (int n = 0; n < 2; ++n) *(f32x4*)(x1 + off + bj * HALF + n * 16) = xv[m][bj][n] + gv[bj][n] * acc[ai][bj][m][n]; } }
    }
};
struct EpiMoe1 {
    static constexpr bool PERM = true;
    unsigned char* act; const float* b1; float ascale;
    __device__ __forceinline__ void operator()(const f32x4 (&acc)[2][2][4][2], const Unit& u, int wr, int wc, int fr, int fq) const {
        const int row0 = u.pm * BM + wr * 64 + fr, c0 = u.pn * HALF + wc * 32 + 8 * fq;
        const float* bp = b1 + (size_t)u.e * 4096 + c0;
        f32x4 bg[2], bu[2];
#pragma unroll
        for (int n = 0; n < 2; ++n) { bg[n] = *(const f32x4*)(bp + 4 * n); bu[n] = *(const f32x4*)(bp + 2048 + 4 * n); }
#pragma unroll
        for (int ai = 0; ai < 2; ++ai)
#pragma unroll
            for (int m = 0; m < 4; ++m) { unsigned char* rowp = act + (size_t)(row0 + ai * HALF + m * 16) * DFF + c0;
                float o[8];
#pragma unroll
                for (int n = 0; n < 2; ++n)
#pragma unroll
                    for (int j = 0; j < 4; ++j) { float g = acc[ai][0][m][n][j] * ascale + bg[n][j], up = acc[ai][1][m][n][j] * ascale + bu[n][j];
                        g = fminf(g, 7.0f); up = fminf(fmaxf(up, -7.0f), 7.0f);
                        const float glu = g * __builtin_amdgcn_rcpf(1.0f + __expf(-1.702f * g));
                        o[n * 4 + j] = (up + 1.0f) * glu; }
                int w0 = 0, w1 = 0;
                w0 = __builtin_amdgcn_cvt_pk_fp8_f32(o[0], o[1], w0, false); w0 = __builtin_amdgcn_cvt_pk_fp8_f32(o[2], o[3], w0, true);
                w1 = __builtin_amdgcn_cvt_pk_fp8_f32(o[4], o[5], w1, false); w1 = __builtin_amdgcn_cvt_pk_fp8_f32(o[6], o[7], w1, true);
                *(u32x2*)rowp = (u32x2){(unsigned)w0, (unsigned)w1}; }
    }
};

struct PlainSched {
    const char* A; const char* Bt; int K; int nM, nN, nwg, G, c; int pn_off = 0;
    __device__ __forceinline__ void init(const void* A_, const void* Bt_, int M, int N, int Kbytes, int G_, int c_) { A = (const char*)A_; Bt = (const char*)Bt_; K = Kbytes; nM = M / BM; nN = N / BM; nwg = nM * nN; G = G_; c = c_; }
    __device__ __forceinline__ bool tile(int i, int& pm, int& pn) const {
        const long L = (long)i * G + c; if (L >= nwg || i >= NSLOT) return false;
        int wgid = (int)L; { const int q = nwg / NXCD, r = nwg % NXCD, xcd = wgid % NXCD, off = wgid / NXCD; wgid = (xcd < r ? xcd * (q + 1) : r * (q + 1) + (xcd - r) * q) + off; }
        const int WGM = 8, nig = WGM * nN, gid = wgid / nig, fm = gid * WGM, gsz = (nM - fm) < WGM ? (nM - fm) : WGM;
        pm = fm + ((wgid % nig) % gsz); pn = (wgid % nig) / gsz; return true;
    }
    __device__ __forceinline__ bool next(int i, Unit& u) const {
        int pm, pn; if (!tile(i, pm, pn)) return false;
        u.A = A; u.B0 = Bt + (size_t)pn * BM * K; u.B1 = u.B0 + (size_t)HALF * K; u.slot = i; u.pm = pm; u.pn = pn + pn_off; u.e = 0; return true;
    }
    __device__ __forceinline__ void a_ready(const Unit&) const {}
    __device__ __forceinline__ void build_tables(LAS unsigned char* lds) const {
        LAS unsigned short* tab = (LAS unsigned short*)(lds + TAB_OFF);
        for (int i = 0; i < NSLOT; ++i) { int pm, pn; if (!tile(i, pm, pn)) break;
            if (threadIdx.x < 256) tab[i * 256 + threadIdx.x] = (unsigned short)(pm * BM + threadIdx.x); }
    }
};
template <int NT  , bool GATHER>
struct MoeSched {
    const char* A; const char* W; LAS const int* et; int nunits, G, c; const int* list; unsigned* flags; unsigned* tmo;
    __device__ __forceinline__ void init(const void* A_, const void* W_, LAS unsigned char* lds, int G_, int c_, const int* list_, unsigned* flags_ = nullptr, unsigned* tmo_ = nullptr) {
        A = (const char*)A_; W = (const char*)W_; et = (LAS const int*)(lds + ETAB_OFF); G = G_; c = c_; list = list_; flags = flags_; tmo = tmo_;
        nunits = __builtin_amdgcn_readfirstlane(et[64 + 32]) * NT;
    }
    __device__ __forceinline__ bool map(int i, int& e, int& nt, int& mt) const {
        const long L = (long)i * G + c; if (L >= nunits || i >= NSLOT) return false;
        int wgid = (int)L; { const int q = nunits / NXCD, r = nunits % NXCD, xcd = wgid % NXCD, off = wgid / NXCD; wgid = (xcd < r ? xcd * (q + 1) : r * (q + 1) + (xcd - r) * q) + off; }
        const int lane = threadIdx.x & 63, le = lane & 31;
        const int t0 = et[64 + le] * NT, t1 = et[64 + le + 1] * NT;
        const unsigned long long hit = __ballot(wgid >= t0 && wgid < t1);
        e = __builtin_amdgcn_readfirstlane((int)__builtin_ctzll(hit)) & 31;
        const int ub = __builtin_amdgcn_readfirstlane(et[64 + e]) * NT, tl = __builtin_amdgcn_readfirstlane(et[32 + e]);
        const int local = wgid - ub; nt = local / tl; mt = local - nt * tl; return true;
    }
    __device__ __forceinline__ bool next(int i, Unit& u) const {
        int e, nt, mt; if (!map(i, e, nt, mt)) return false;
        const int tb = __builtin_amdgcn_readfirstlane(et[64 + e]);
        u.A = A; u.slot = i; u.pm = tb + mt; u.pn = nt; u.e = e;
        if (NT == 16) { u.B0 = W + ((size_t)e * 4096 + (size_t)nt * HALF) * DM; u.B1 = u.B0 + (size_t)2048 * DM; }
        else { u.B0 = W + ((size_t)e * 2048 + (size_t)nt * BM) * DFF; u.B1 = u.B0 + (size_t)HALF * DFF; }
        return true;
    }
    __device__ __forceinline__ void a_ready(const Unit& u) const {
        if (flags == nullptr) return;
        if (threadIdx.x < 64) {
            unsigned* w = flags + 64 * (u.e * 16 + u.pn); unsigned spins = 0;
            while ((unsigned)__builtin_amdgcn_readfirstlane(__hip_atomic_load(w, __ATOMIC_RELAXED, __HIP_MEMORY_SCOPE_AGENT)) < 128u) {
                __builtin_amdgcn_s_sleep(2);
                if ((++spins & 255u) == 0u) { if (__builtin_amdgcn_readfirstlane(__hip_atomic_load(tmo, __ATOMIC_RELAXED, __HIP_MEMORY_SCOPE_AGENT)) != 0u) break;
                    if (spins > (1u << 20)) { if (threadIdx.x == 0) __hip_atomic_store(tmo, 1u, __ATOMIC_RELAXED, __HIP_MEMORY_SCOPE_AGENT); break; } } }
            __builtin_amdgcn_fence(__ATOMIC_ACQUIRE, "agent");
            asm volatile("s_waitcnt vmcnt(0)" ::: "memory");
        }
        asm volatile("" ::: "memory"); __builtin_amdgcn_s_barrier(); asm volatile("" ::: "memory");
    }
    __device__ __forceinline__ void build_tables(LAS unsigned char* lds) const {
        LAS unsigned short* tab = (LAS unsigned short*)(lds + TAB_OFF);
        for (int i = 0; i < NSLOT; ++i) { int e, nt, mt; if (!map(i, e, nt, mt)) break;
            if (threadIdx.x < 256) { int row;
                if (GATHER) { const int pos = mt * BM + (int)threadIdx.x; const int cnt = et[e]; row = pos < cnt ? list[e * 8192 + pos] : 0; }
                else row = (et[64 + e] + mt) * BM + (int)threadIdx.x;
                tab[i * 256 + threadIdx.x] = (unsigned short)row; } }
    }
};
}

namespace att {
constexpr int D = 128, NW = 8, QBLK = 32, KVBLK = 64;
constexpr float SCALE = 0.088388347648318440f;
constexpr float THR = 8.f;
constexpr int SHM_V = KVBLK * D * 2, SHM_K = KVBLK * D * 2, SHM_ATTN = 2 * SHM_V + 2 * SHM_K + NW * 64 * 4;
#define KSWZ(row, colB) ((row) * 256 + ((colB) ^ (((row) & 7) << 4)))
#define SBAR() __builtin_amdgcn_sched_barrier(0)
__device__ __forceinline__ int crow(int r, int hi) { return (r & 3) + 8 * (r >> 2) + 4 * hi; }
__device__ __forceinline__ void partialSM(f32x16& p0, f32x16& p1, float& m_reg, float& mn, float& alpha) {
  constexpr float C = SCALE * 1.4426950408889634f;
  float pmax = p0[0];
#pragma unroll
  for (int r = 1; r < 16; ++r) pmax = fmaxf(pmax, p0[r]);
#pragma unroll
  for (int r = 0; r < 16; ++r) pmax = fmaxf(pmax, p1[r]);
  { auto rr = __builtin_amdgcn_permlane32_swap(__float_as_uint(pmax), __float_as_uint(pmax), false, false);
    pmax = fmaxf(__uint_as_float(rr[0]), __uint_as_float(rr[1])); }
  if (__builtin_expect(__all(pmax - m_reg <= THR / SCALE), 1)) { mn = m_reg; alpha = 1.f; }
  else { mn = fmaxf(m_reg, pmax); alpha = __builtin_amdgcn_exp2f((m_reg - mn) * C); m_reg = mn; }
  float mnC = -mn * C;
#pragma unroll
  for (int r = 0; r < 16; ++r) p0[r] = fmaf(p0[r], C, mnC);
#pragma unroll
  for (int r = 0; r < 16; ++r) p1[r] = fmaf(p1[r], C, mnC);
#pragma unroll
  for (int r = 0; r < 16; ++r) p0[r] = __builtin_amdgcn_exp2f(p0[r]);
}
#define PK4(P, BASE, OUT) do { unsigned a0 = cvt_pk_bf16(P[BASE + 0], P[BASE + 1]), a1 = cvt_pk_bf16(P[BASE + 2], P[BASE + 3]);   \
    unsigned b0 = cvt_pk_bf16(P[BASE + 4], P[BASE + 5]), b1 = cvt_pk_bf16(P[BASE + 6], P[BASE + 7]);                              \
    auto r0 = __builtin_amdgcn_permlane32_swap(a0, b0, false, false); auto r1 = __builtin_amdgcn_permlane32_swap(a1, b1, false, false); \
    u32x4 w = {r0[0], r1[0], r0[1], r1[1]}; OUT = *reinterpret_cast<bf16x8*>(&w); } while (0)
__device__ __forceinline__ void finishSM(f32x16& p0, f32x16& p1, float alpha, float& l_reg, bf16x8& pa0, bf16x8& pa1, bf16x8& pa2, bf16x8& pa3) {
#pragma unroll
  for (int r = 0; r < 16; ++r) p1[r] = __builtin_amdgcn_exp2f(p1[r]);
  float ps = 0;
#pragma unroll
  for (int r = 0; r < 16; ++r) ps += p0[r];
#pragma unroll
  for (int r = 0; r < 16; ++r) ps += p1[r];
  { auto rr = __builtin_amdgcn_permlane32_swap(__float_as_uint(ps), __float_as_uint(ps), false, false);
    ps = __uint_as_float(rr[0]) + __uint_as_float(rr[1]); }
  l_reg = l_reg * alpha + ps;
  PK4(p0, 0, pa0); PK4(p0, 8, pa1); PK4(p1, 0, pa2); PK4(p1, 8, pa3);
}
__device__ __forceinline__ void qkt(f32x16& p0, f32x16& p1, const char* Ks, const bf16x8* qr, int r32, int hi) {
  p0 = f32x16{}; p1 = f32x16{};
#pragma unroll
  for (int d0 = 0; d0 < 8; ++d0) { int cb = (d0 * 16 + hi * 8) * 2;
    bf16x8 b0 = *reinterpret_cast<const bf16x8*>(Ks + KSWZ(r32, cb));
    bf16x8 b1 = *reinterpret_cast<const bf16x8*>(Ks + KSWZ(32 + r32, cb));
    p0 = __builtin_amdgcn_mfma_f32_32x32x16_bf16(b0, qr[d0], p0, 0, 0, 0);
    p1 = __builtin_amdgcn_mfma_f32_32x32x16_bf16(b1, qr[d0], p1, 0, 0, 0); }
}
__device__ __forceinline__ int v_st(int k, int c) { const int kk = (k & ~0xC) | ((k & 4) << 1) | ((k & 8) >> 1); return ((kk >> 3) * 4 + (c >> 5)) * 512 + ((kk & 7) * 32 + (c & 31)) * 2; }
__device__ __forceinline__ int v_rd_base(int lane) { return ((lane & 3) << 3) | (((lane >> 2) & 3) << 6) | (((lane >> 4) & 1) << 5) | (((lane >> 5) & 1) << 8); }
constexpr int v_rd_off(int d0, int ks, int half) { return d0 * 512 + ks * 4096 + half * 2048; }
template <int OFF> __device__ __forceinline__ s16x4 tr_read(int vb) {
  s16x4 r; asm volatile("ds_read_b64_tr_b16 %0, %1 offset:%2" : "=&v"(r) : "v"(vb), "i"(OFF) : "memory"); return r;
}
#define PKLH(L, H) (bf16x8){L[0], L[1], L[2], L[3], H[0], H[1], H[2], H[3]}
template <int D0> __device__ __forceinline__ void pv_one(f32x16& od, int vb, bf16x8 pa0, bf16x8 pa1, bf16x8 pa2, bf16x8 pa3) {
  const s16x4 l0 = tr_read<v_rd_off(D0, 0, 0)>(vb), h0 = tr_read<v_rd_off(D0, 0, 1)>(vb), l1 = tr_read<v_rd_off(D0, 1, 0)>(vb), h1 = tr_read<v_rd_off(D0, 1, 1)>(vb);
  const s16x4 l2 = tr_read<v_rd_off(D0, 2, 0)>(vb), h2 = tr_read<v_rd_off(D0, 2, 1)>(vb), l3 = tr_read<v_rd_off(D0, 3, 0)>(vb), h3 = tr_read<v_rd_off(D0, 3, 1)>(vb);
  asm volatile("s_waitcnt lgkmcnt(0)" ::: "memory"); SBAR();
  od = __builtin_amdgcn_mfma_f32_32x32x16_bf16(pa0, PKLH(l0, h0), od, 0, 0, 0);
  od = __builtin_amdgcn_mfma_f32_32x32x16_bf16(pa1, PKLH(l1, h1), od, 0, 0, 0);
  od = __builtin_amdgcn_mfma_f32_32x32x16_bf16(pa2, PKLH(l2, h2), od, 0, 0, 0);
  od = __builtin_amdgcn_mfma_f32_32x32x16_bf16(pa3, PKLH(l3, h3), od, 0, 0, 0);
}
__device__ __forceinline__ void pv_d0(f32x16* o, int vb, bf16x8 pa0, bf16x8 pa1, bf16x8 pa2, bf16x8 pa3) {
  pv_one<0>(o[0], vb, pa0, pa1, pa2, pa3); pv_one<1>(o[1], vb, pa0, pa1, pa2, pa3); pv_one<2>(o[2], vb, pa0, pa1, pa2, pa3); pv_one<3>(o[3], vb, pa0, pa1, pa2, pa3);
}
template <int LDQ, int LDK, int LDO, bool OUT8>
__device__ __forceinline__ void attn_dense_body(const bf16_t* __restrict__ Qb, const bf16_t* __restrict__ Kh, const bf16_t* __restrict__ Vh,
                                                void* __restrict__ Ob_, int seq, char* lds) {
  const int tid = threadIdx.x, wid = tid >> 6, lane = tid & 63, r32 = lane & 31, hi = lane >> 5;
  char* V_lds = lds; char* K_lds = lds + 2 * SHM_V;
  float* ws = (float*)(lds + 2 * SHM_V + 2 * SHM_K) + wid * 64; float* li_l = ws; float* al_l = ws + 32;
  float m_reg = -1e30f, l_reg = 0; f32x16 o[4] = {}; bf16x8 qr[8];
  const bf16_t* Qw = Qb + (long)(wid * QBLK + r32) * LDQ + hi * 8;
#pragma unroll
  for (int d0 = 0; d0 < 8; ++d0) qr[d0] = *reinterpret_cast<const bf16x8*>(Qw + d0 * 16);
  const int sr = tid >> 4, sc = (tid & 15) * 8, vst0 = v_st(sr, sc), vst1 = v_st(32 + sr, sc);
  const int vb0 = (int)(uintptr_t)V_lds + v_rd_base(lane);
  struct { bf16x8 vs0, vs1, ks0, ks1; } sr_[2];
#define SLOAD(i, k0) do { sr_[i].vs0 = *reinterpret_cast<const bf16x8*>(&Vh[(long)((k0) + sr) * LDK + sc]); sr_[i].vs1 = *reinterpret_cast<const bf16x8*>(&Vh[(long)((k0) + 32 + sr) * LDK + sc]); \
    sr_[i].ks0 = *reinterpret_cast<const bf16x8*>(&Kh[(long)((k0) + sr) * LDK + sc]); sr_[i].ks1 = *reinterpret_cast<const bf16x8*>(&Kh[(long)((k0) + 32 + sr) * LDK + sc]); } while (0)
#define SWRITE(b, i) do { *(bf16x8*)(V_lds + (b) * SHM_V + vst0) = sr_[i].vs0;          \
    *(bf16x8*)(V_lds + (b) * SHM_V + vst1) = sr_[i].vs1; int kc = sc * 2;               \
    *(bf16x8*)(K_lds + (b) * SHM_K + KSWZ(sr, kc)) = sr_[i].ks0;                       \
    *(bf16x8*)(K_lds + (b) * SHM_K + KSWZ(32 + sr, kc)) = sr_[i].ks1; } while (0)
#define SWAIT() asm volatile("s_waitcnt vmcnt(4)" ::: "memory")
#define RESC(a) do { if (__any((a) < 1.f)) { if (hi == 0) al_l[r32] = (a); asm volatile("s_waitcnt lgkmcnt(0)" ::: "memory"); \
    _Pragma("unroll") for (int d = 0; d < 4; ++d) _Pragma("unroll") for (int r = 0; r < 16; ++r) o[d][r] *= al_l[crow(r, hi)]; } } while (0)
  f32x16 pA0, pA1, pB0, pB1; float mnA, mnB, alA, alB; bf16x8 pa0, pa1, pa2, pa3; const int NT = seq / KVBLK;
  constexpr int SE = 0, SO = 1;
  SLOAD(SE, 0); asm volatile("s_waitcnt vmcnt(0)" ::: "memory"); SWRITE(0, SE); __syncthreads();
  qkt(pA0, pA1, K_lds, qr, r32, hi); partialSM(pA0, pA1, m_reg, mnA, alA);
  SLOAD(SO, KVBLK); if (2 < NT) SLOAD(SE, 2 * KVBLK);
  SWAIT(); SWRITE(1, SO); __syncthreads();
  for (int j = 1; j + 1 < NT; j += 2) {
    SBAR(); qkt(pB0, pB1, K_lds + SHM_K, qr, r32, hi);
    finishSM(pA0, pA1, alA, l_reg, pa0, pa1, pa2, pa3); SBAR();
    SLOAD(SO, (j + 2) * KVBLK); SBAR();
    pv_d0(o, vb0, pa0, pa1, pa2, pa3); partialSM(pB0, pB1, m_reg, mnB, alB);
    __syncthreads(); SWAIT(); SWRITE(0, SE);
    RESC(alB); __syncthreads();
    SBAR(); qkt(pA0, pA1, K_lds, qr, r32, hi);
    finishSM(pB0, pB1, alB, l_reg, pa0, pa1, pa2, pa3); SBAR();
    if (j + 3 < NT) SLOAD(SE, (j + 3) * KVBLK); SBAR();
    pv_d0(o, vb0 + (int)SHM_V, pa0, pa1, pa2, pa3); partialSM(pA0, pA1, m_reg, mnA, alA);
    __syncthreads(); SWAIT(); SWRITE(1, SO);
    RESC(alA); __syncthreads();
  }
  SBAR(); qkt(pB0, pB1, K_lds + SHM_K, qr, r32, hi);
  finishSM(pA0, pA1, alA, l_reg, pa0, pa1, pa2, pa3); SBAR();
  pv_d0(o, vb0, pa0, pa1, pa2, pa3); partialSM(pB0, pB1, m_reg, mnB, alB);
  __syncthreads(); RESC(alB);
  finishSM(pB0, pB1, alB, l_reg, pa0, pa1, pa2, pa3); SBAR();
  pv_d0(o, vb0 + (int)SHM_V, pa0, pa1, pa2, pa3);
  if (hi == 0) li_l[r32] = l_reg; asm volatile("s_waitcnt lgkmcnt(0)" ::: "memory");
  float rli[16];
#pragma unroll
  for (int r = 0; r < 16; ++r) rli[r] = __builtin_amdgcn_rcpf(li_l[crow(r, hi)]);
  if constexpr (OUT8) { unsigned char* Ow = (unsigned char*)Ob_ + (long)(wid * QBLK) * LDO;
#pragma unroll
    for (int r = 0; r < 16; ++r) { int orow = crow(r, hi);
#pragma unroll
      for (int d0 = 0; d0 < 4; ++d0) { const float v = o[d0][r] * rli[r] * 8.0f; Ow[(long)orow * LDO + d0 * 32 + r32] = (unsigned char)(__builtin_amdgcn_cvt_pk_fp8_f32(v, v, 0, false) & 0xff); } }
  } else { bf16_t* Ow = (bf16_t*)Ob_ + (long)(wid * QBLK) * LDO;
#pragma unroll
    for (int r = 0; r < 16; ++r) { int orow = crow(r, hi);
#pragma unroll
      for (int d0 = 0; d0 < 4; ++d0) { const float v = o[d0][r] * rli[r]; Ow[(long)orow * LDO + d0 * 32 + r32] = (bf16_t)(cvt_pk_bf16(v, v) & 0xffffu); } } }
  __syncthreads();
#undef SLOAD
#undef SWRITE
#undef SWAIT
#undef RESC
}

typedef int i32x8a __attribute__((ext_vector_type(8)));
__device__ __forceinline__ int k8_off(int row, int c) { return row * 128 + ((c ^ ((row >> 1) & 7)) << 4); }
__device__ __forceinline__ i32x8a ld32(const char* p0, const char* p1) { const u32x4 a = *reinterpret_cast<const u32x4*>(p0), b = *reinterpret_cast<const u32x4*>(p1); return (i32x8a){(int)a.x, (int)a.y, (int)a.z, (int)a.w, (int)b.x, (int)b.y, (int)b.z, (int)b.w}; }
__device__ __forceinline__ void qkt8(f32x16& p0, f32x16& p1, const char* Ks, const i32x8a* qf, int r32, int hi) {
  p0 = f32x16{}; p1 = f32x16{};
#pragma unroll
  for (int s = 0; s < 2; ++s) { const int c0 = 4 * s + 2 * hi;
    const i32x8a a0 = ld32(Ks + k8_off(r32, c0), Ks + k8_off(r32, c0 + 1)), a1 = ld32(Ks + k8_off(32 + r32, c0), Ks + k8_off(32 + r32, c0 + 1));
    p0 = __builtin_amdgcn_mfma_scale_f32_32x32x64_f8f6f4(a0, qf[s], p0, 0, 0, 0, 0x7f7f7f7f, 0, 0x7f7f7f7f);
    p1 = __builtin_amdgcn_mfma_scale_f32_32x32x64_f8f6f4(a1, qf[s], p1, 0, 0, 0, 0x7f7f7f7f, 0, 0x7f7f7f7f); }
}
template <int LDQ8, int LDK8, int LDV, int LDO>
__device__ __forceinline__ void attn_dense_body_q8(const unsigned char* __restrict__ Qb8, const unsigned char* __restrict__ Kh8, const bf16_t* __restrict__ Vh,
                                                   bf16_t* __restrict__ Ob, int seq, char* lds) {
  const int tid = threadIdx.x, wid = tid >> 6, lane = tid & 63, r32 = lane & 31, hi = lane >> 5;
  char* V_lds = lds; char* K_lds = lds + 2 * SHM_V;
  float* ws = (float*)(lds + 2 * SHM_V + 2 * SHM_K) + wid * 64; float* li_l = ws; float* al_l = ws + 32;
  float m_reg = -1e30f, l_reg = 0; f32x16 o[4] = {}; i32x8a qf[2];
  { const unsigned char* Qw = Qb8 + (long)(wid * QBLK + r32) * LDQ8 + 32 * hi;
#pragma unroll
    for (int s = 0; s < 2; ++s) qf[s] = ld32((const char*)Qw + 64 * s, (const char*)Qw + 64 * s + 16); }
  const int sr = tid >> 4, sc = (tid & 15) * 8, vst0 = v_st(sr, sc), vst1 = v_st(32 + sr, sc);
  const int kr = tid >> 3, kc = tid & 7, kst = k8_off(kr, kc);
  const int vb0 = (int)(uintptr_t)V_lds + v_rd_base(lane);
  struct { bf16x8 vs0, vs1; u32x4 ks; } sr_[2];
#define SLOAD(i, k0) do { sr_[i].vs0 = *reinterpret_cast<const bf16x8*>(&Vh[(long)((k0) + sr) * LDV + sc]); sr_[i].vs1 = *reinterpret_cast<const bf16x8*>(&Vh[(long)((k0) + 32 + sr) * LDV + sc]); \
    sr_[i].ks = *reinterpret_cast<const u32x4*>(&Kh8[(long)((k0) + kr) * LDK8 + 16 * kc]); } while (0)
#define SWRITE(b, i) do { *(bf16x8*)(V_lds + (b) * SHM_V + vst0) = sr_[i].vs0; *(bf16x8*)(V_lds + (b) * SHM_V + vst1) = sr_[i].vs1; \
    *(u32x4*)(K_lds + (b) * SHM_K + kst) = sr_[i].ks; } while (0)
#define SWAIT() asm volatile("s_waitcnt vmcnt(3)" ::: "memory")
#define RESC(a) do { if (__any((a) < 1.f)) { if (hi == 0) al_l[r32] = (a); asm volatile("s_waitcnt lgkmcnt(0)" ::: "memory"); \
    _Pragma("unroll") for (int d = 0; d < 4; ++d) _Pragma("unroll") for (int r = 0; r < 16; ++r) o[d][r] *= al_l[crow(r, hi)]; } } while (0)
  f32x16 pA0, pA1, pB0, pB1; float mnA, mnB, alA, alB; bf16x8 pa0, pa1, pa2, pa3; const int NT = seq / KVBLK;
  constexpr int SE = 0, SO = 1;
  SLOAD(SE, 0); asm volatile("s_waitcnt vmcnt(0)" ::: "memory"); SWRITE(0, SE); __syncthreads();
  qkt8(pA0, pA1, K_lds, qf, r32, hi); partialSM(pA0, pA1, m_reg, mnA, alA);
  SLOAD(SO, KVBLK); if (2 < NT) SLOAD(SE, 2 * KVBLK);
  SWAIT(); SWRITE(1, SO); __syncthreads();
  for (int j = 1; j + 1 < NT; j += 2) {
    SBAR(); qkt8(pB0, pB1, K_lds + SHM_K, qf, r32, hi);
    finishSM(pA0, pA1, alA, l_reg, pa0, pa1, pa2, pa3); SBAR();
    SLOAD(SO, (j + 2) * KVBLK); SBAR();
    pv_d0(o, vb0, pa0, pa1, pa2, pa3); partialSM(pB0, pB1, m_reg, mnB, alB);
    __syncthreads(); SWAIT(); SWRITE(0, SE);
    RESC(alB); __syncthreads();
    SBAR(); qkt8(pA0, pA1, K_lds, qf, r32, hi);
    finishSM(pB0, pB1, alB, l_reg, pa0, pa1, pa2, pa3); SBAR();
    if (j + 3 < NT) SLOAD(SE, (j + 3) * KVBLK); SBAR();
    pv_d0(o, vb0 + (int)SHM_V, pa0, pa1, pa2, pa3); partialSM(pA0, pA1, m_reg, mnA, alA);
    __syncthreads(); SWAIT(); SWRITE(1, SO);
    RESC(alA); __syncthreads();
  }
  SBAR(); qkt8(pB0, pB1, K_lds + SHM_K, qf, r32, hi);
  finishSM(pA0, pA1, alA, l_reg, pa0, pa1, pa2, pa3); SBAR();
  pv_d0(o, vb0, pa0, pa1, pa2, pa3); partialSM(pB0, pB1, m_reg, mnB, alB);
  __syncthreads(); RESC(alB);
  finishSM(pB0, pB1, alB, l_reg, pa0, pa1, pa2, pa3); SBAR();
  pv_d0(o, vb0 + (int)SHM_V, pa0, pa1, pa2, pa3);
  if (hi == 0) li_l[r32] = l_reg; asm volatile("s_waitcnt lgkmcnt(0)" ::: "memory");
  float rli[16];
#pragma unroll
  for (int r = 0; r < 16; ++r) rli[r] = __builtin_amdgcn_rcpf(li_l[crow(r, hi)]);
  bf16_t* Ow = Ob + (long)(wid * QBLK) * LDO;
#pragma unroll
  for (int r = 0; r < 16; ++r) { int orow = crow(r, hi);
#pragma unroll
    for (int d0 = 0; d0 < 4; ++d0) { const float v = o[d0][r] * rli[r]; Ow[(long)orow * LDO + d0 * 32 + r32] = (bf16_t)(cvt_pk_bf16(v, v) & 0xffffu); } }
  __syncthreads();
#undef SLOAD
#undef SWRITE
#undef SWAIT
#undef RESC
}

__device__ __forceinline__ int v8_off(int row, int c) { return row * 64 + ((c ^ ((row >> 2) & 3)) << 4); }
__device__ __forceinline__ void partialSM5(f32x16& p0, f32x16& p1, float& m_reg, float& mn, float& alpha) {
  constexpr float C = SCALE * 1.4426950408889634f, THR5 = 5.f;
  float pmax = p0[0];
#pragma unroll
  for (int r = 1; r < 16; ++r) pmax = fmaxf(pmax, p0[r]);
#pragma unroll
  for (int r = 0; r < 16; ++r) pmax = fmaxf(pmax, p1[r]);
  { auto rr = __builtin_amdgcn_permlane32_swap(__float_as_uint(pmax), __float_as_uint(pmax), false, false);
    pmax = fmaxf(__uint_as_float(rr[0]), __uint_as_float(rr[1])); }
  if (__builtin_expect(__all(pmax - m_reg <= THR5 / SCALE), 1)) { mn = m_reg; alpha = 1.f; }
  else { mn = fmaxf(m_reg, pmax); alpha = __builtin_amdgcn_exp2f((m_reg - mn) * C); m_reg = mn; }
  float mnC = -mn * C;
#pragma unroll
  for (int r = 0; r < 16; ++r) p0[r] = fmaf(p0[r], C, mnC);
#pragma unroll
  for (int r = 0; r < 16; ++r) p1[r] = fmaf(p1[r], C, mnC);
#pragma unroll
  for (int r = 0; r < 16; ++r) p0[r] = __builtin_amdgcn_exp2f(p0[r]);
}
__device__ __forceinline__ void finishSM8(f32x16& p0, f32x16& p1, float alpha, float& l_reg, i32x8a& pf) {
#pragma unroll
  for (int r = 0; r < 16; ++r) p1[r] = __builtin_amdgcn_exp2f(p1[r]);
  float ps = 0;
#pragma unroll
  for (int r = 0; r < 16; ++r) ps += p0[r];
#pragma unroll
  for (int r = 0; r < 16; ++r) ps += p1[r];
  { auto rr = __builtin_amdgcn_permlane32_swap(__float_as_uint(ps), __float_as_uint(ps), false, false);
    ps = __uint_as_float(rr[0]) + __uint_as_float(rr[1]); }
  l_reg = l_reg * alpha + ps;
#pragma unroll
  for (int q = 0; q < 4; ++q) { int w = 0; w = __builtin_amdgcn_cvt_pk_fp8_f32(p0[4 * q], p0[4 * q + 1], w, false); w = __builtin_amdgcn_cvt_pk_fp8_f32(p0[4 * q + 2], p0[4 * q + 3], w, true); pf[q] = w; }
#pragma unroll
  for (int q = 0; q < 4; ++q) { int w = 0; w = __builtin_amdgcn_cvt_pk_fp8_f32(p1[4 * q], p1[4 * q + 1], w, false); w = __builtin_amdgcn_cvt_pk_fp8_f32(p1[4 * q + 2], p1[4 * q + 3], w, true); pf[4 + q] = w; }
}
__device__ __forceinline__ void pv8(f32x16* o, const char* Vs, const i32x8a pf, int r32, int hi) {
#pragma unroll
  for (int d0 = 0; d0 < 4; ++d0) { const int row = 32 * d0 + r32;
    const i32x8a vf = ld32(Vs + v8_off(row, 2 * hi), Vs + v8_off(row, 2 * hi + 1));
    o[d0] = __builtin_amdgcn_mfma_scale_f32_32x32x64_f8f6f4(pf, vf, o[d0], 0, 0, 0, 0x7f7f7f7f, 0, 0x7f7f7f7f); }
}
template <int LDQ8, int LDK8, int LDO>
__device__ __forceinline__ void attn_dense_body_q8v8(const unsigned char* __restrict__ Qb8, const unsigned char* __restrict__ Kh8, const unsigned char* __restrict__ Vt8  ,
                                                     bf16_t* __restrict__ Ob, int seq, char* lds) {
  const int tid = threadIdx.x, wid = tid >> 6, lane = tid & 63, r32 = lane & 31, hi = lane >> 5;
  char* V_lds = lds; char* K_lds = lds + 2 * SHM_V;
  float* ws = (float*)(lds + 2 * SHM_V + 2 * SHM_K) + wid * 64; float* li_l = ws; float* al_l = ws + 32;
  float m_reg = -1e30f, l_reg = 0; f32x16 o[4] = {}; i32x8a qf[2];
  { const unsigned char* Qw = Qb8 + (long)(wid * QBLK + r32) * LDQ8 + 32 * hi;
#pragma unroll
    for (int s = 0; s < 2; ++s) qf[s] = ld32((const char*)Qw + 64 * s, (const char*)Qw + 64 * s + 16); }
  const int kr = tid >> 3, kc = tid & 7, kst = k8_off(kr, kc);
  const int vr = tid >> 2, vc = tid & 3, vst = v8_off(vr, vc);
  struct { u32x4 vs, ks; } sr_[2];
#define SLOAD(i, k0) do { sr_[i].vs = *reinterpret_cast<const u32x4*>(Vt8 + (long)((k0) >> 6) * 8192 + tid * 16); \
    sr_[i].ks = *reinterpret_cast<const u32x4*>(&Kh8[(long)((k0) + kr) * LDK8 + 16 * kc]); } while (0)
#define SWRITE(b, i) do { *(u32x4*)(V_lds + (b) * SHM_V + vst) = sr_[i].vs; *(u32x4*)(K_lds + (b) * SHM_K + kst) = sr_[i].ks; } while (0)
#define SWAIT() asm volatile("s_waitcnt vmcnt(2)" ::: "memory")
#define RESC(a) do { if (__any((a) < 1.f)) { if (hi == 0) al_l[r32] = (a); asm volatile("s_waitcnt lgkmcnt(0)" ::: "memory"); \
    _Pragma("unroll") for (int d = 0; d < 4; ++d) _Pragma("unroll") for (int r = 0; r < 16; ++r) o[d][r] *= al_l[crow(r, hi)]; } } while (0)
  f32x16 pA0, pA1, pB0, pB1; float mnA, mnB, alA, alB; i32x8a pf; const int NT = seq / KVBLK;
  constexpr int SE = 0, SO = 1;
  SLOAD(SE, 0); asm volatile("s_waitcnt vmcnt(0)" ::: "memory"); SWRITE(0, SE); __syncthreads();
  qkt8(pA0, pA1, K_lds, qf, r32, hi); partialSM5(pA0, pA1, m_reg, mnA, alA);
  SLOAD(SO, KVBLK); if (2 < NT) SLOAD(SE, 2 * KVBLK);
  SWAIT(); SWRITE(1, SO); __syncthreads();
  for (int j = 1; j + 1 < NT; j += 2) {
    SBAR(); qkt8(pB0, pB1, K_lds + SHM_K, qf, r32, hi);
    finishSM8(pA0, pA1, alA, l_reg, pf); SBAR();
    SLOAD(SO, (j + 2) * KVBLK); SBAR();
    pv8(o, V_lds, pf, r32, hi); partialSM5(pB0, pB1, m_reg, mnB, alB);
    __syncthreads(); SWAIT(); SWRITE(0, SE);
    RESC(alB); __syncthreads();
    SBAR(); qkt8(pA0, pA1, K_lds, qf, r32, hi);
    finishSM8(pB0, pB1, alB, l_reg, pf); SBAR();
    if (j + 3 < NT) SLOAD(SE, (j + 3) * KVBLK); SBAR();
    pv8(o, V_lds + SHM_V, pf, r32, hi); partialSM5(pA0, pA1, m_reg, mnA, alA);
    __syncthreads(); SWAIT(); SWRITE(1, SO);
    RESC(alA); __syncthreads();
  }
  SBAR(); qkt8(pB0, pB1, K_lds + SHM_K, qf, r32, hi);
  finishSM8(pA0, pA1, alA, l_reg, pf); SBAR();
  pv8(o, V_lds, pf, r32, hi); partialSM5(pB0, pB1, m_reg, mnB, alB);
  __syncthreads(); RESC(alB);
  finishSM8(pB0, pB1, alB, l_reg, pf); SBAR();
  pv8(o, V_lds + SHM_V, pf, r32, hi);
  if (hi == 0) li_l[r32] = l_reg; asm volatile("s_waitcnt lgkmcnt(0)" ::: "memory");
  float rli[16];
#pragma unroll
  for (int r = 0; r < 16; ++r) rli[r] = __builtin_amdgcn_rcpf(li_l[crow(r, hi)]);
  bf16_t* Ow = Ob + (long)(wid * QBLK) * LDO;
#pragma unroll
  for (int r = 0; r < 16; ++r) { int orow = crow(r, hi);
#pragma unroll
    for (int d0 = 0; d0 < 4; ++d0) { const float v = o[d0][r] * rli[r]; Ow[(long)orow * LDO + d0 * 32 + r32] = (bf16_t)(cvt_pk_bf16(v, v) & 0xffffu); } }
  __syncthreads();
#undef SLOAD
#undef SWRITE
#undef SWAIT
#undef RESC
}
}

struct Args { const float* in[21]; float* out; unsigned char* ws; int ph_lo, ph_hi; };
enum { I_X = 0, I_C, I_CTX, I_CCTX, I_WMOD, I_BMOD, I_GN1, I_WIN, I_BIN, I_GQ, I_GK, I_GML, I_WOUT, I_GN2, I_WR, I_BR, I_W1, I_B1, I_W2, I_B2, I_GF };
struct Frame { LAS unsigned char* lds; char* ldsg; int tid, lane, wave, vcu, G; unsigned char* ws; };
constexpr int NWAVES = 8, NTHR = 512;

__device__ __forceinline__ void cvt_item(const float* __restrict__ W, int ldw, bf16_t* __restrict__ WT, int item, int nblk, int lane) {
    const int kb = item / nblk, nb = item - kb * nblk, k0 = 64 * kb, n0 = 32 * nb, kg = lane >> 3, ng = lane & 7;
    const float* src = W + (size_t)(k0 + 8 * kg) * ldw + n0 + 4 * ng;
    f32x4 v[8];
#pragma unroll
    for (int i = 0; i < 8; ++i) v[i] = __builtin_nontemporal_load((const f32x4*)(src + (size_t)i * ldw));
    bf16_t* dst = WT + (size_t)(n0 + 4 * ng) * 2048 + k0 + 8 * kg;
#pragma unroll
    for (int j = 0; j < 4; ++j) { u32x4 w; w.x = cvt_pk_bf16(v[0][j], v[1][j]); w.y = cvt_pk_bf16(v[2][j], v[3][j]); w.z = cvt_pk_bf16(v[4][j], v[5][j]); w.w = cvt_pk_bf16(v[6][j], v[7][j]);
        __builtin_nontemporal_store(w, (u32x4*)(dst + (size_t)j * 2048)); }
}
template <bool WT_SC1>
__device__ __forceinline__ void cvt_item8(const float* __restrict__ W, int ldw, unsigned char* __restrict__ WT, int kb, int n0, int lane, float scale = 64.0f) {
    const int k0 = 128 * kb, kg = lane >> 3, ng = lane & 7;
    const float* src = W + (size_t)(k0 + 16 * kg) * ldw + n0 + 4 * ng;
    f32x4 v[16];
#pragma unroll
    for (int i = 0; i < 16; ++i) v[i] = __builtin_nontemporal_load((const f32x4*)(src + (size_t)i * ldw)) * scale;
    unsigned char* dst = WT + (size_t)(n0 + 4 * ng) * 2048 + k0 + 16 * kg;
#pragma unroll
    for (int j = 0; j < 4; ++j) { int w[4];
#pragma unroll
        for (int q = 0; q < 4; ++q) { w[q] = 0; w[q] = __builtin_amdgcn_cvt_pk_fp8_f32(v[4 * q][j], v[4 * q + 1][j], w[q], false); w[q] = __builtin_amdgcn_cvt_pk_fp8_f32(v[4 * q + 2][j], v[4 * q + 3][j], w[q], true); }
        const u32x4 o = {(unsigned)w[0], (unsigned)w[1], (unsigned)w[2], (unsigned)w[3]};
        if constexpr (WT_SC1) { const __amdgpu_buffer_rsrc_t rs = __builtin_amdgcn_make_buffer_rsrc((void*)WT, 0, 4096 * 2048, 0x00020000);
            __builtin_amdgcn_raw_buffer_store_b128(o, rs, (unsigned)((n0 + 4 * ng + j) * 2048 + k0 + 16 * kg), 0, 16); }
        else __builtin_nontemporal_store(o, (u32x4*)(dst + (size_t)j * 2048)); }
}
__device__ __forceinline__ void cvt_dispatch(const Args& a, unsigned char* ws, int it, int lane) {
    constexpr int NB_SKIP = ATTN_PROJ8 ? 48 : 0;
    constexpr int I_IN = INPROJ_FP8 ? 16 * 144 : 32 * (144 - NB_SKIP), I_IN8 = ATTN_PROJ8 ? 16 * 48 : 0, I_OUT = PROJ_FP8 ? 16 * 64 : 32 * 64;
    int r = it;
    if (r < I_IN) {
#if INPROJ_FP8
        cvt_item8<false>(a.in[I_WIN], IN_COLS, ws + WS_WINT, r / 144, 32 * (r % 144), lane);
#else
        cvt_item(a.in[I_WIN] + 32 * NB_SKIP, IN_COLS, (bf16_t*)(ws + WS_WINT) + (size_t)(32 * NB_SKIP) * DM, r, 144 - NB_SKIP, lane);
#endif
        return; }
    r -= I_IN;
    if (r < I_IN8) { cvt_item8<false>(a.in[I_WIN], IN_COLS, ws + WS_WIN8, r / 48, 32 * (r % 48), lane); return; }
    r -= I_IN8;
    if (r < I_OUT) {
#if PROJ_FP8
        const int kb = r >> 6; cvt_item8<false>(a.in[I_WOUT], DM, ws + WS_WOUTT, kb, 32 * (r & 63), lane, kb < 8 ? 8.0f : 64.0f);
#else
        cvt_item(a.in[I_WOUT], DM, (bf16_t*)(ws + WS_WOUTT), r, 64, lane);
#endif
        return; }
}
constexpr int CVT_NITEMS = (INPROJ_FP8 ? 16 * 144 : 32 * (144 - (ATTN_PROJ8 ? 48 : 0))) + (ATTN_PROJ8 ? 16 * 48 : 0) + (PROJ_FP8 ? 16 * 64 : 32 * 64);
__device__ __forceinline__ void p0_phase(const Args& a, Frame& F) {
    float* mod = (float*)(F.ws + WS_MOD);
    for (int wg = F.vcu; wg < 192; wg += F.G) {
        LAS float* sil = (LAS float*)F.lds; LAS float* red = (LAS float*)(F.lds + 24576);
        __syncthreads();
        for (int idx = F.tid; idx < 3 * 2048; idx += NTHR) { const float v = idx < 4096 ? a.in[I_C][idx] : a.in[I_CCTX][idx - 4096]; sil[idx] = v / (1.0f + __expf(-v)); }
        __syncthreads();
        const int kg = F.tid >> 4, cq = F.tid & 15, col = 64 * wg + 4 * cq;
        f32x4 acc[3] = {};
        const float* wp = a.in[I_WMOD] + (size_t)(kg * 64) * 12288 + col;
#pragma unroll 8
        for (int kk = 0; kk < 64; ++kk) { const f32x4 w = __builtin_nontemporal_load((const f32x4*)(wp + (size_t)kk * 12288)); const int k = kg * 64 + kk;
            acc[0] += sil[k] * w; acc[1] += sil[2048 + k] * w; acc[2] += sil[4096 + k] * w; }
#pragma unroll
        for (int r = 0; r < 3; ++r)
#pragma unroll
            for (int j = 0; j < 4; ++j) red[(kg * 3 + r) * 64 + 4 * cq + j] = acc[r][j];
        __syncthreads();
        if (F.tid < 192) { const int r = F.tid >> 6, cc = F.tid & 63; float s = 0.f;
            for (int g = 0; g < 32; ++g) s += red[(g * 3 + r) * 64 + cc];
            mod[r * 12288 + 64 * wg + cc] = s + a.in[I_BMOD][64 * wg + cc]; }
    }
    const int gw = F.vcu * NWAVES + F.wave, NGW = F.G * NWAVES;
    {
#if INPROJ_FP8 || PROJ_FP8
        unsigned char* WT = F.ws + WS_WINT + (size_t)PW * DM;
        for (int idx = F.vcu * NTHR + F.tid; idx < 256 * DM; idx += F.G * NTHR) { const int n = idx >> 11, k = idx & 2047;
            const float v = n < 16 ? 64.0f * a.in[I_WIN][(size_t)k * IN_COLS + C_G + n] : 0.f; WT[idx] = (unsigned char)(__builtin_amdgcn_cvt_pk_fp8_f32(v, v, 0, false) & 0xff); }
#else
        bf16_t* WT = (bf16_t*)(F.ws + WS_WINT) + (size_t)PW * DM;
        for (int idx = F.vcu * NTHR + F.tid; idx < 256 * DM; idx += F.G * NTHR) { const int n = idx >> 11, k = idx & 2047;
            const float v = n < 16 ? a.in[I_WIN][(size_t)k * IN_COLS + C_G + n] : 0.f; WT[idx] = (bf16_t)(cvt_pk_bf16(v, v) & 0xffffu); }
#endif
    }
    for (int it = gw; it < CVT_NITEMS; it += NGW) cvt_dispatch(a, F.ws, it, F.lane);
}

__device__ __forceinline__ void p1_phase(const Args& a, Frame& F) {
    const float* mod = (const float*)(F.ws + WS_MOD);
    const int gw = F.vcu * NWAVES + F.wave, NGW = F.G * NWAVES;
    bf16_t* H = (bf16_t*)(F.ws + WS_H);
    for (int R = gw; R < MROWS; R += NGW) {
        const int b = R / ROWS_B, r = R - b * ROWS_B; const bool lat = r < SEQ;
        const float* src = lat ? a.in[I_X] + ((size_t)(b * SEQ + r)) * DM : a.in[I_CTX] + ((size_t)(b * CTXL + r - SEQ)) * DM;
        const float* mrow = mod + (size_t)(lat ? b : 2) * 12288;
        f32x4 v[8], gg[8], scv[8], shv[8]; float ss = 0.f;
#pragma unroll
        for (int j = 0; j < 8; ++j) { const int k = 4 * F.lane + 256 * j; v[j] = *(const f32x4*)(src + k); gg[j] = *(const f32x4*)(a.in[I_GN1] + k); scv[j] = *(const f32x4*)(mrow + 2048 + k); shv[j] = *(const f32x4*)(mrow + k); }
        __builtin_amdgcn_sched_barrier(0);
#pragma unroll
        for (int j = 0; j < 8; ++j) ss += (v[j].x * v[j].x + v[j].y * v[j].y) + (v[j].z * v[j].z + v[j].w * v[j].w);
        const float rstd = 1.0f / sqrtf(wave_sum(ss) * (1.0f / DM) + EPS);
#pragma unroll
        for (int j = 0; j < 8; ++j) { const int k = 4 * F.lane + 256 * j;
            const f32x4 g = gg[j], sc = scv[j], sh = shv[j];
            const f32x4 hv = v[j] * rstd * g * (sc + 1.0f) + sh;
#if INPROJ_FP8 || PROJ_FP8
            int w = 0; w = __builtin_amdgcn_cvt_pk_fp8_f32(hv.x, hv.y, w, false); w = __builtin_amdgcn_cvt_pk_fp8_f32(hv.z, hv.w, w, true);
            *(int*)((unsigned char*)H + (size_t)R * DM + k) = w; }
#else
            u32x2 w; w.x = cvt_pk_bf16(hv.x, hv.y); w.y = cvt_pk_bf16(hv.z, hv.w);
            *(u32x2*)(H + (size_t)R * DM + k) = w;
#if ATTN_PROJ8
            { int w8 = 0; w8 = __builtin_amdgcn_cvt_pk_fp8_f32(hv.x, hv.y, w8, false); w8 = __builtin_amdgcn_cvt_pk_fp8_f32(hv.z, hv.w, w8, true); *(int*)(F.ws + WS_H8 + (size_t)R * DM + k) = w8; }
#endif
            }
#endif
    }

}

__device__ __forceinline__ float wave_scan_add(float v, int lane) {
#pragma unroll
    for (int o = 1; o < 64; o <<= 1) { const float t = __shfl_up(v, o); if (lane >= o) v += t; }
    return v;
}
__device__ __forceinline__ float wave_scan_max(float v, int lane) {
#pragma unroll
    for (int o = 1; o < 64; o <<= 1) { const float t = __shfl_up(v, o); if (lane >= o) v = fmaxf(v, t); }
    return v;
}
__device__ __forceinline__ float log_sigmoid(float f) { return fminf(f, 0.f) - log1pf(__expf(-fabsf(f))); }
__device__ __forceinline__ void chunk_scan_task(const float* gate, float* GA, float* GM, float* GB, float* GC, int chain, int tb, int lane, LAS float* a_lds, LAS float* amax_lds) {
    const int b = chain >> 3, dir = (chain >> 2) & 1, h = chain & 3;
    const int j0 = 2 * lane, j1 = j0 + 1;
    const int s0 = dir == 0 ? j0 : 127 - j0, s1i = dir == 0 ? j1 : 127 - j1; const int r0 = tb * 128 + s0, r1 = tb * 128 + s1i;
    const float* g0 = gate + (size_t)(b * ROWS_B + r0) * 16; const float* g1 = gate + (size_t)(b * ROWS_B + r1) * 16;
    const float lf0 = log_sigmoid(g0[8 + dir * 4 + h]), lf1 = log_sigmoid(g1[8 + dir * 4 + h]), i0 = g0[dir * 4 + h], i1 = g1[dir * 4 + h];
    const float s1 = lf0 + lf1; const float incl = wave_scan_add(s1, lane), excl = incl - s1;
    const float b0 = excl + lf0, b1 = excl + s1;
    const float a0 = i0 - b0, a1 = i1 - b1; const float m1 = fmaxf(a0, a1);
    const float im = wave_scan_max(m1, lane); float ex = __shfl_up(im, 1); if (lane == 0) ex = -3.0e38f;
    const float c0 = fmaxf(ex, a0), c1 = fmaxf(ex, m1);
    const size_t o = (size_t)chain * ROWS_B;
    GA[o + r0] = a0; GA[o + r1] = a1; GM[o + r0] = c0; GM[o + r1] = c1; GB[o + r0] = b0; GB[o + r1] = b1;
    if (lane == 63) { float* gc = GC + (size_t)(chain * NTB + tb) * 4; gc[0] = b1; gc[1] = c1; }
    if (a_lds != nullptr) { a_lds[s0] = a0; a_lds[s1i] = a1; if (lane == 63) amax_lds[0] = c1; }
}
__device__ __forceinline__ void p3_phase(const Args& a, Frame& F) {
    LAS float* cs = (LAS float*)F.lds; LAS float* sn = (LAS float*)(F.lds + 8192);
    LAS float* gi = (LAS float*)(F.lds + 16384); LAS float* gf = (LAS float*)(F.lds + 16384 + 17408);
    __syncthreads();
    for (int idx = F.tid; idx < 2048; idx += NTHR) { const int pos = idx >> 5, fi = idx & 31; const float inv = exp2f(-(float)fi * 0.41524101186092029f); const float ang = (float)pos * inv;
        cs[idx] = cosf(ang); sn[idx] = sinf(ang); }
    __syncthreads();
    bf16_t* P = (bf16_t*)(F.ws + WS_P);
    const int gw = F.vcu * NWAVES + F.wave, NGW = F.G * NWAVES;
    const int sub = F.lane >> 4, l16 = F.lane & 15, e0 = 8 * l16;
    for (int R = gw; R < MROWS; R += NGW) {
        const int b = R / ROWS_B, r = R - b * ROWS_B; const bool lat = r < SEQ;
        u32x4 raws[3]; bool act[3]; bf16_t* ptr[3];
#pragma unroll
        for (int step = 0; step < 3; ++step) {
            const int s_ = step * 4 + sub; const bool isq = s_ < 8; act[step] = isq ? lat : (s_ < 10);
            const int colb = isq ? s_ * 128 : C_K + (s_ - 8) * 128;
            ptr[step] = P + (size_t)R * PW + colb + e0;
            raws[step] = (u32x4){0u, 0u, 0u, 0u}; if (act[step]) raws[step] = *(const u32x4*)ptr[step];
        }
        __builtin_amdgcn_sched_barrier(0);
#pragma unroll
        for (int step = 0; step < 3; ++step) {
            const int s_ = step * 4 + sub; const bool isq = s_ < 8; const u32x4 raw = raws[step];
            float y[8]; y[0] = bflo(raw.x); y[1] = bfhi(raw.x); y[2] = bflo(raw.y); y[3] = bfhi(raw.y); y[4] = bflo(raw.z); y[5] = bfhi(raw.z); y[6] = bflo(raw.w); y[7] = bfhi(raw.w);
            float ss = 0.f;
#pragma unroll
            for (int i = 0; i < 8; ++i) ss += y[i] * y[i];
            ss += __shfl_xor(ss, 1); ss += __shfl_xor(ss, 2); ss += __shfl_xor(ss, 4); ss += __shfl_xor(ss, 8);
            const float rstd = 1.0f / sqrtf(ss * (1.0f / HD) + EPS);
            const float* g = (isq ? a.in[I_GQ] : a.in[I_GK]) + e0;
#pragma unroll
            for (int i = 0; i < 8; ++i) y[i] = y[i] * rstd * g[i];
            if (lat) {
                const int posr = r >> 6, posc = r & 63;
#pragma unroll
                for (int i = 0; i < 4; ++i) { const int pp = 4 * l16 + i; const int pos = pp < 32 ? posr : posc; const int ti = pos * 32 + (pp & 31);
                    const float c = cs[ti], sv = sn[ti]; const float x1 = y[2 * i], x2 = y[2 * i + 1]; y[2 * i] = x1 * c - x2 * sv; y[2 * i + 1] = x1 * sv + x2 * c; }
            }
#if ATT_QK8
            if (act[step]) { int w0 = 0, w1 = 0;
                w0 = __builtin_amdgcn_cvt_pk_fp8_f32(y[0], y[1], w0, false); w0 = __builtin_amdgcn_cvt_pk_fp8_f32(y[2], y[3], w0, true);
                w1 = __builtin_amdgcn_cvt_pk_fp8_f32(y[4], y[5], w1, false); w1 = __builtin_amdgcn_cvt_pk_fp8_f32(y[6], y[7], w1, true);
                unsigned char* dst = isq ? F.ws + WS_Q8 + ((size_t)(b * SEQ + r)) * 1024 + s_ * 128 + e0 : F.ws + WS_K8 + (size_t)R * 256 + (s_ - 8) * 128 + e0;
                *(u32x2*)dst = (u32x2){(unsigned)w0, (unsigned)w1}; }
#else
            if (act[step]) { u32x4 w; w.x = cvt_pk_bf16(y[0], y[1]); w.y = cvt_pk_bf16(y[2], y[3]); w.z = cvt_pk_bf16(y[4], y[5]); w.w = cvt_pk_bf16(y[6], y[7]); *(u32x4*)ptr[step] = w; }
#endif
        }
    }
    const float* mod = (const float*)(F.ws + WS_MOD);
    float* wrs = (float*)(F.ws + WS_WRS);
    for (int idx = F.vcu * NTHR + F.tid; idx < 2 * 65536; idx += F.G * NTHR) { const int b = idx >> 16, k = (idx >> 5) & 2047;
        wrs[idx] = a.in[I_GN2][k] * (1.0f + mod[b * 12288 + 8192 + k]) * a.in[I_WR][idx & 65535]; }
    for (int be = F.vcu; be < 64; be += F.G) {
        const int b = be >> 5, e = be & 31; float s = 0.f;
#pragma unroll
        for (int i = 0; i < 4; ++i) { const int k = F.tid + NTHR * i; s += mod[b * 12288 + 6144 + k] * a.in[I_WR][k * 32 + e]; }
        s = wave_sum(s);
        LAS float* red = (LAS float*)F.lds;
        __syncthreads();
        if (F.lane == 0) red[F.wave] = s;
        __syncthreads();
        if (F.tid == 0) { float t = 0.f; for (int w = 0; w < NWAVES; ++w) t += red[w]; wrs[2 * 65536 + be] = t + a.in[I_BR][e]; }
    }
}

__device__ __forceinline__ int chain_tb(int dir, int c) { return dir == 0 ? (c < 2 ? 32 + c : c - 2) : 33 - c; }
__device__ __forceinline__ int chain_pos(int dir, int tb) { return dir == 0 ? (tb < 32 ? tb + 2 : tb - 32) : 33 - tb; }
__device__ __forceinline__ void chain_scan(const float* GC, int chain, int dir, int lane, float& mp_c, float& am_c) {
    const int c = lane < NTB ? lane : NTB - 1; const float* gc = GC + (size_t)(chain * NTB + chain_tb(dir, c)) * 4;
    const float x = gc[0], y = gc[1]; float m = 0.f, mp = 0.f;
#pragma unroll
    for (int i = 0; i < NTB; ++i) { if (lane == i) mp = m; m = __shfl(x, i) + fmaxf(m, __shfl(y, i)); }
    mp_c = mp; am_c = y;
}

__device__ __forceinline__ void p4_phase(const Args& a, Frame& F) {
    using namespace att;
    const bf16_t* P = (const bf16_t*)(F.ws + WS_P);
    const float* GA = (const float*)(F.ws + WS_GA); const float* GC = (const float*)(F.ws + WS_GC);
    float* LST = (float*)(F.ws + WS_LST); float* NL = (float*)(F.ws + WS_NL);
    char* Vimg = F.ldsg; char* Kimg = F.ldsg + 65536; LAS float* wsc = (LAS float*)(F.lds + TAB_OFF);
    for (int u = F.vcu; u < NB * MH * NTB; u += F.G) {
        const int b = u / (MH * NTB), h = (u / NTB) % MH, tb = u % NTB;
        int tid = F.tid; asm volatile("" : "+v"(tid));
        const int lane = tid & 63, r32 = lane & 31, hi = lane >> 5;
        const size_t rowbase = (size_t)b * ROWS_B + tb * 128;
        __syncthreads();
        if (F.wave < 2) chunk_scan_task((const float*)(F.ws + WS_GATE), (float*)(F.ws + WS_GA), (float*)(F.ws + WS_GM), (float*)(F.ws + WS_GB), (float*)(F.ws + WS_GC),
                                        (b * 2 + F.wave) * 4 + h, tb, lane, wsc + 512 + F.wave * 128, wsc + 256 + F.wave);
        __syncthreads();
        if (tid < 256) { const int dir = tid >> 7;
            wsc[tid] = 0.088388347648318440f * __expf(wsc[512 + tid] - wsc[256 + dir]); }
        __syncthreads();
        bf16x8 sv[8]; u32x4 sk[4];
#pragma unroll
        for (int i = 0; i < 8; ++i) { const int p = tid + NTHR * i, s = p >> 5, c8 = (p & 31) * 8; sv[i] = *(const bf16x8*)(P + (rowbase + s) * PW + C_MV + h * 256 + c8); }
#pragma unroll
        for (int i = 0; i < 4; ++i) { const int p = tid + NTHR * i, s = p >> 4, c8 = (p & 15) * 8; sk[i] = *(const u32x4*)(P + (rowbase + s) * PW + C_MK + h * 128 + c8); }
        __builtin_amdgcn_sched_barrier(0);
#pragma unroll
        for (int i = 0; i < 8; ++i) { const int p = tid + NTHR * i, s = p >> 5, c8 = (p & 31) * 8;
            *(bf16x8*)(Vimg + ((s >> 6) * 2 + (c8 >> 7)) * 16384 + v_st(s & 63, c8 & 127)) = sv[i]; }
#pragma unroll
        for (int i = 0; i < 4; ++i) { const int p = tid + NTHR * i, s = p >> 4, c8 = (p & 15) * 8;
            const u32x4 raw = sk[i];
            float y[8]; y[0] = bflo(raw.x); y[1] = bfhi(raw.x); y[2] = bflo(raw.y); y[3] = bfhi(raw.y); y[4] = bflo(raw.z); y[5] = bfhi(raw.z); y[6] = bflo(raw.w); y[7] = bfhi(raw.w);
#pragma unroll
            for (int dir = 0; dir < 2; ++dir) { const float w = wsc[dir * 128 + s];
                u32x4 o; o.x = cvt_pk_bf16(y[0] * w, y[1] * w); o.y = cvt_pk_bf16(y[2] * w, y[3] * w); o.z = cvt_pk_bf16(y[4] * w, y[5] * w); o.w = cvt_pk_bf16(y[6] * w, y[7] * w);
                *(u32x4*)(Kimg + (dir * 2 + (s >> 6)) * 16384 + v_st(s & 63, c8)) = o; } }
        __syncthreads();
        const int vh = F.wave >> 2, vb = F.wave & 3;
        f32x16 acc[2][4];
#pragma unroll
        for (int d = 0; d < 2; ++d)
#pragma unroll
            for (int q = 0; q < 4; ++q) acc[d][q] = f32x16{};
#pragma unroll
        for (int kt = 0; kt < 2; ++kt) {
            const int baseA = (int)(uintptr_t)Vimg + (kt * 2 + vh) * 16384 + vb * 512 + v_rd_base(lane);
            const int baseB0 = (int)(uintptr_t)Kimg + (0 * 2 + kt) * 16384 + v_rd_base(lane);
            const int baseB1 = (int)(uintptr_t)Kimg + (1 * 2 + kt) * 16384 + v_rd_base(lane);
#define P4_STEP(KS) do { \
            const s16x4 al = tr_read<v_rd_off(0, KS, 0)>(baseA), ah = tr_read<v_rd_off(0, KS, 1)>(baseA); \
            const s16x4 b00l = tr_read<v_rd_off(0, KS, 0)>(baseB0), b00h = tr_read<v_rd_off(0, KS, 1)>(baseB0), b01l = tr_read<v_rd_off(1, KS, 0)>(baseB0), b01h = tr_read<v_rd_off(1, KS, 1)>(baseB0); \
            const s16x4 b02l = tr_read<v_rd_off(2, KS, 0)>(baseB0), b02h = tr_read<v_rd_off(2, KS, 1)>(baseB0), b03l = tr_read<v_rd_off(3, KS, 0)>(baseB0), b03h = tr_read<v_rd_off(3, KS, 1)>(baseB0); \
            const s16x4 b10l = tr_read<v_rd_off(0, KS, 0)>(baseB1), b10h = tr_read<v_rd_off(0, KS, 1)>(baseB1), b11l = tr_read<v_rd_off(1, KS, 0)>(baseB1), b11h = tr_read<v_rd_off(1, KS, 1)>(baseB1); \
            const s16x4 b12l = tr_read<v_rd_off(2, KS, 0)>(baseB1), b12h = tr_read<v_rd_off(2, KS, 1)>(baseB1), b13l = tr_read<v_rd_off(3, KS, 0)>(baseB1), b13h = tr_read<v_rd_off(3, KS, 1)>(baseB1); \
            asm volatile("s_waitcnt lgkmcnt(0)" ::: "memory"); SBAR(); \
            const bf16x8 af = PKLH(al, ah); \
            acc[0][0] = __builtin_amdgcn_mfma_f32_32x32x16_bf16(af, PKLH(b00l, b00h), acc[0][0], 0, 0, 0); acc[0][1] = __builtin_amdgcn_mfma_f32_32x32x16_bf16(af, PKLH(b01l, b01h), acc[0][1], 0, 0, 0); \
            acc[0][2] = __builtin_amdgcn_mfma_f32_32x32x16_bf16(af, PKLH(b02l, b02h), acc[0][2], 0, 0, 0); acc[0][3] = __builtin_amdgcn_mfma_f32_32x32x16_bf16(af, PKLH(b03l, b03h), acc[0][3], 0, 0, 0); \
            acc[1][0] = __builtin_amdgcn_mfma_f32_32x32x16_bf16(af, PKLH(b10l, b10h), acc[1][0], 0, 0, 0); acc[1][1] = __builtin_amdgcn_mfma_f32_32x32x16_bf16(af, PKLH(b11l, b11h), acc[1][1], 0, 0, 0); \
            acc[1][2] = __builtin_amdgcn_mfma_f32_32x32x16_bf16(af, PKLH(b12l, b12h), acc[1][2], 0, 0, 0); acc[1][3] = __builtin_amdgcn_mfma_f32_32x32x16_bf16(af, PKLH(b13l, b13h), acc[1][3], 0, 0, 0); \
        } while (0)
            P4_STEP(0); P4_STEP(1); P4_STEP(2); P4_STEP(3);
#undef P4_STEP
        }
#pragma unroll
        for (int dir = 0; dir < 2; ++dir) { const int chain = (b * 2 + dir) * 4 + h; float* Lp = LST + ((size_t)(chain * NTB + tb) * 256 + 32 * F.wave) * 128;
#pragma unroll
            for (int q = 0; q < 4; ++q)
#pragma unroll
                for (int rr = 0; rr < 16; ++rr) Lp[(size_t)crow(rr, hi) * 128 + 32 * q + r32] = acc[dir][q][rr]; }
        if (tid < 256) { const int dir = tid >> 7, d = tid & 127; const int chain = (b * 2 + dir) * 4 + h; float s = 0.f;
            for (int ss = 0; ss < 128; ++ss) s += bf2f(*(const unsigned short*)(Kimg + (dir * 2 + (ss >> 6)) * 16384 + v_st(ss & 63, d & ~7) + (d & 7) * 2));
            NL[(size_t)(chain * NTB + tb) * 128 + d] = s; }
    }
    __syncthreads();
}

__device__ __forceinline__ void p5_phase(const Args& a, Frame& F) {
    const float* __restrict__ LST = (const float*)(F.ws + WS_LST); const float* __restrict__ NL = (const float*)(F.ws + WS_NL); const float* GC = (const float*)(F.ws + WS_GC); float* GCw = (float*)(F.ws + WS_GC);
    bf16_t* __restrict__ CST = (bf16_t*)(F.ws + WS_CST); float* __restrict__ NST = (float*)(F.ws + WS_NST);
    for (int u = F.vcu; u < NCHAIN * 16; u += F.G) {
        const int chain = u >> 4, part = u & 15, dir = (chain >> 2) & 1; const size_t e0 = (size_t)part * 2048 + F.tid * 4;
        LAS float* dec_l = (LAS float*)F.lds;
        __syncthreads();
        if (F.wave == 0) { float mp, am; chain_scan(GC, chain, dir, F.lane, mp, am);
            if (F.lane < NTB) { const float MT = fmaxf(mp, am); dec_l[F.lane] = __expf(mp - MT); dec_l[64 + F.lane] = __expf(am - MT);
                if (part == 0) GCw[(size_t)(chain * NTB + chain_tb(dir, F.lane)) * 4 + 2] = mp; } }
        __syncthreads();
        f32x4 C = {0.f, 0.f, 0.f, 0.f}; float n = 0.f; const bool don = (part == 0 && F.tid < 128);
#pragma unroll 2
        for (int c = 0; c < NTB; ++c) {
            const int tb = dir == 0 ? (c < 2 ? 32 + c : c - 2) : 33 - c;
            if (tb < 32) { u32x2 w; w.x = cvt_pk_bf16(C.x, C.y); w.y = cvt_pk_bf16(C.z, C.w); *(u32x2*)(CST + (size_t)(chain * 32 + tb) * 32768 + e0) = w;
                if (don) NST[(size_t)(chain * 32 + tb) * 128 + F.tid] = n; }
            if (c < NTB - 1) { const float dec = dec_l[c], fac = dec_l[64 + c];
                const f32x4 L = *(const f32x4*)(LST + (size_t)(chain * NTB + tb) * 32768 + e0); C = dec * C + fac * L;
                if (don) n = dec * n + fac * NL[(size_t)(chain * NTB + tb) * 128 + F.tid]; }
        }
    }
}

__device__ __forceinline__ void p6_attention(const Args& a, Frame& F) {
    const bf16_t* P = (const bf16_t*)(F.ws + WS_P); bf16_t* Y = (bf16_t*)(F.ws + WS_Y);
    for (int u = F.vcu; u < 256; u += F.G) {
        const int x = u >> 5, idx = u & 31, b = x >> 2, kvh = (x >> 1) & 1, qhalf = x & 1, g = idx >> 3, qblk = qhalf * 8 + (idx & 7), head = kvh * 4 + g;
        const bf16_t* Qb = P + ((size_t)b * ROWS_B + qblk * 256) * PW + C_Q + head * 128;
        const bf16_t* Kh = P + ((size_t)b * ROWS_B) * PW + C_K + kvh * 128;
        const bf16_t* Vh = P + ((size_t)b * ROWS_B) * PW + C_V + kvh * 128;
        __syncthreads();
#if PROJ_FP8
        att::attn_dense_body<PW, PW, DM, true>(Qb, Kh, Vh, (unsigned char*)Y + ((size_t)b * SEQ + qblk * 256) * DM + head * 128, ROWS_B, F.ldsg);
#else
#if ATT_QK8 && ATT_PV8
        att::attn_dense_body_q8v8<1024, 256, DM>(F.ws + WS_Q8 + ((size_t)b * SEQ + qblk * 256) * 1024 + head * 128, F.ws + WS_K8 + ((size_t)b * ROWS_B) * 256 + kvh * 128,
                                                 F.ws + WS_VT8 + (size_t)((b * 2 + kvh) * (ROWS_B / 64)) * 8192, Y + ((size_t)b * SEQ + qblk * 256) * DM + head * 128, ROWS_B, F.ldsg);
#elif ATT_QK8
        att::attn_dense_body_q8<1024, 256, PW, DM>(F.ws + WS_Q8 + ((size_t)b * SEQ + qblk * 256) * 1024 + head * 128, F.ws + WS_K8 + ((size_t)b * ROWS_B) * 256 + kvh * 128, Vh,
                                                   Y + ((size_t)b * SEQ + qblk * 256) * DM + head * 128, ROWS_B, F.ldsg);
#else
        att::attn_dense_body<PW, PW, DM, false>(Qb, Kh, Vh, Y + ((size_t)b * SEQ + qblk * 256) * DM + head * 128, ROWS_B, F.ldsg);
#endif
#endif
    }
}
__device__ __forceinline__ void p6_mlstm_out(const Args& a, Frame& F) {
    using namespace att;
    const bf16_t* P = (const bf16_t*)(F.ws + WS_P); bf16_t* Y = (bf16_t*)(F.ws + WS_Y);
    const float* GA = (const float*)(F.ws + WS_GA); const float* GM = (const float*)(F.ws + WS_GM); const float* GB = (const float*)(F.ws + WS_GB); const float* GC = (const float*)(F.ws + WS_GC);
    const bf16_t* CST = (const bf16_t*)(F.ws + WS_CST); const float* NST = (const float*)(F.ws + WS_NST);
    char* Vimg = F.ldsg; char* Kimg = F.ldsg + 65536;
    LAS float* ga_l = (LAS float*)(F.lds + 98304);
    LAS float* nst_l = (LAS float*)(F.lds + 98304 + 1024);
    LAS float* xw = (LAS float*)(F.lds + 98304 + 2048);
    LAS float* ssx = (LAS float*)(F.lds + 98304 + 4096);
    LAS float* mpv = (LAS float*)(F.lds + 98304 + 5120);
    const int wq = F.wave & 1, vq = F.wave >> 1, vh = vq >> 1, vsub = vq & 1;
    LAS float* myx = xw + F.wave * 64;
    for (int u = F.vcu; u < NB * MH * 32; u += F.G) {
        const int b = u >> 7, h = (u >> 5) & 3, lb = u & 31;
        int tid = F.tid; asm volatile("" : "+v"(tid));
        const int lane = tid & 63, r32 = lane & 31, hi = lane >> 5;
        const size_t rowbase = (size_t)b * ROWS_B + lb * 128;
        __syncthreads();
        { bf16x8 sv[8], sk[4];
#pragma unroll
          for (int i = 0; i < 8; ++i) { const int p = tid + NTHR * i, s = p >> 5, c8 = (p & 31) * 8; sv[i] = *(const bf16x8*)(P + (rowbase + s) * PW + C_MV + h * 256 + c8); }
#pragma unroll
          for (int i = 0; i < 4; ++i) { const int p = tid + NTHR * i, s = p >> 4, c8 = (p & 15) * 8; sk[i] = *(const bf16x8*)(P + (rowbase + s) * PW + C_MK + h * 128 + c8); }
          __builtin_amdgcn_sched_barrier(0);
#pragma unroll
          for (int i = 0; i < 8; ++i) { const int p = tid + NTHR * i, s = p >> 5, c8 = (p & 31) * 8; *(bf16x8*)(Vimg + ((s >> 6) * 2 + (c8 >> 7)) * 16384 + v_st(s & 63, c8 & 127)) = sv[i]; }
#pragma unroll
          for (int i = 0; i < 4; ++i) { const int p = tid + NTHR * i, s = p >> 4, c8 = (p & 15) * 8; *(bf16x8*)(Kimg + (s >> 6) * 16384 + KSWZ(s & 63, c8 * 2)) = sk[i]; } }
        if (tid < 256) { const int dir = tid >> 7, s = tid & 127; const int chain = (b * 2 + dir) * 4 + h;
            ga_l[tid] = GA[(size_t)chain * ROWS_B + lb * 128 + s]; nst_l[tid] = NST[(size_t)(chain * 32 + lb) * 128 + s]; }
        if (tid < 2) { const int chain = (b * 2 + tid) * 4 + h; mpv[tid] = GC[(size_t)(chain * NTB + lb) * 4 + 2]; }
#pragma unroll 1
        for (int rh = 0; rh < 2; ++rh) {
        if (rh) __syncthreads();
        int tid_h = tid; asm volatile("" : "+v"(tid_h));
        const int lane = tid_h & 63, r32 = lane & 31, hi = lane >> 5;
        const int t = rh * 64 + wq * 32 + r32;
        bf16x8 qr[8];
        { const bf16_t* Qw = P + (rowbase + t) * PW + C_MQ + h * 128 + hi * 8;
#pragma unroll
          for (int d0 = 0; d0 < 8; ++d0) qr[d0] = *reinterpret_cast<const bf16x8*>(Qw + d0 * 16); }
        __syncthreads();
        f32x16 hsum[2];
        hsum[0] = f32x16{}; hsum[1] = f32x16{};
#pragma unroll 1
        for (int dir = 0; dir < 2; ++dir) {
            const int chain = (b * 2 + dir) * 4 + h;
            const float mprev = mpv[dir];
            const float Mt = fmaxf(mprev, GM[(size_t)chain * ROWS_B + lb * 128 + t]), bt = GB[(size_t)chain * ROWS_B + lb * 128 + t];
            const float winter = __expf(mprev - Mt);
            f32x16 o[2]; o[0] = f32x16{}; o[1] = f32x16{};
            const bf16_t* Cb = CST + ((size_t)(chain * 32 + lb) * 256 + vq * 64 + r32) * 128 + hi * 8;
            { bf16x8 cf[8][2];
#pragma unroll
              for (int ds = 0; ds < 8; ++ds)
#pragma unroll
                for (int q = 0; q < 2; ++q) cf[ds][q] = *reinterpret_cast<const bf16x8*>(Cb + (size_t)q * 32 * 128 + ds * 16);
              __builtin_amdgcn_sched_barrier(0);
#pragma unroll
              for (int ds = 0; ds < 8; ++ds)
#pragma unroll
                for (int q = 0; q < 2; ++q) o[q] = __builtin_amdgcn_mfma_f32_32x32x16_bf16(qr[ds], cf[ds][q], o[q], 0, 0, 0); }
            float qn = 0.f;
#pragma unroll
            for (int ds = 0; ds < 8; ++ds)
#pragma unroll
                for (int j = 0; j < 8; ++j) qn += bf2f((unsigned short)qr[ds][j]) * nst_l[dir * 128 + ds * 16 + hi * 8 + j];
            { auto rr = __builtin_amdgcn_permlane32_swap(__float_as_uint(qn), __float_as_uint(qn), false, false); qn = __uint_as_float(rr[0]) + __uint_as_float(rr[1]); }
            if (hi == 0) myx[r32] = winter;
            LDS_WAIT();
#pragma unroll
            for (int rr = 0; rr < 16; ++rr) { const float w = myx[crow(rr, hi)]; o[0][rr] *= w; o[1][rr] *= w; }
            float rowsum = 0.f;
            int tt = t; asm volatile("" : "+v"(tt));
#pragma unroll
            for (int kt = 0; kt < 2; ++kt) {
                if ((dir == 0 && rh == 0 && kt == 1) || (dir == 1 && rh == 1 && kt == 0)) continue;
                f32x16 p0, p1;
                qkt(p0, p1, Kimg + kt * 16384, qr, r32, hi);
#pragma unroll
                for (int rr = 0; rr < 16; ++rr) {
                    const int s0 = kt * 64 + crow(rr, hi), s1 = s0 + 32;
                    const bool ok0 = dir == 0 ? (s0 <= tt) : (s0 >= tt), ok1 = dir == 0 ? (s1 <= tt) : (s1 >= tt);
                    const float e0 = __expf(ga_l[dir * 128 + s0] - Mt), e1 = __expf(ga_l[dir * 128 + s1] - Mt);
                    p0[rr] = ok0 ? p0[rr] * 0.088388347648318440f * e0 : 0.f; p1[rr] = ok1 ? p1[rr] * 0.088388347648318440f * e1 : 0.f;
                    rowsum += p0[rr] + p1[rr];
                }
                bf16x8 pa0, pa1, pa2, pa3;
                PK4(p0, 0, pa0); PK4(p0, 8, pa1); PK4(p1, 0, pa2); PK4(p1, 8, pa3);
                const int vbase = (int)(uintptr_t)Vimg + (kt * 2 + vh) * 16384 + vsub * 1024 + v_rd_base(lane);
                pv_one<0>(o[0], vbase, pa0, pa1, pa2, pa3); pv_one<1>(o[1], vbase, pa0, pa1, pa2, pa3);
            }
            { auto rr = __builtin_amdgcn_permlane32_swap(__float_as_uint(rowsum), __float_as_uint(rowsum), false, false); rowsum = __uint_as_float(rr[0]) + __uint_as_float(rr[1]); }
            const float den = rowsum + winter * qn;
            const float rinv = 1.0f / fmaxf(fabsf(den), __expf(-(bt + Mt)));
            LDS_WAIT();
            if (hi == 0) myx[32 + r32] = rinv;
            LDS_WAIT();
#pragma unroll
            for (int rr = 0; rr < 16; ++rr) { const float w = myx[32 + crow(rr, hi)]; hsum[0][rr] += o[0][rr] * w; hsum[1][rr] += o[1][rr] * w; }
        }
        float ssr[16];
#pragma unroll
        for (int rr = 0; rr < 16; ++rr) { float s = hsum[0][rr] * hsum[0][rr] + hsum[1][rr] * hsum[1][rr];
            s += __shfl_xor(s, 1); s += __shfl_xor(s, 2); s += __shfl_xor(s, 4); s += __shfl_xor(s, 8); s += __shfl_xor(s, 16); ssr[rr] = s; }
        if (r32 == 0) {
#pragma unroll
            for (int rr = 0; rr < 16; ++rr) ssx[vq * 64 + wq * 32 + crow(rr, hi)] = ssr[rr]; }
        __syncthreads();
        const float* gml = a.in[I_GML] + h * 256 + vq * 64 + r32;
        const float g0 = gml[0], g1 = gml[32];
        unsigned short mov[16][2];
#pragma unroll
        for (int rr = 0; rr < 16; ++rr) { const size_t prow = rowbase + rh * 64 + wq * 32 + crow(rr, hi);
#pragma unroll
            for (int q = 0; q < 2; ++q) mov[rr][q] = P[prow * PW + C_MO + h * 256 + vq * 64 + 32 * q + r32]; }
        __builtin_amdgcn_sched_barrier(0);
#pragma unroll
        for (int rr = 0; rr < 16; ++rr) { const int row = wq * 32 + crow(rr, hi);
            const float rn = 1.0f / sqrtf(((ssx[row] + ssx[64 + row]) + (ssx[128 + row] + ssx[192 + row])) * (1.0f / MDV) + EPS);
            const size_t yrow = (size_t)b * SEQ + lb * 128 + rh * 64 + row;
#pragma unroll
            for (int q = 0; q < 2; ++q) { const int v = vq * 64 + 32 * q + r32;
                const float mo = bf2f(mov[rr][q]);
                const float val = hsum[q][rr] * rn * (q == 0 ? g0 : g1) / (1.0f + __expf(-mo));
#if PROJ_FP8
                ((unsigned char*)Y)[yrow * DM + 1024 + h * 256 + v] = (unsigned char)(__builtin_amdgcn_cvt_pk_fp8_f32(val, val, 0, false) & 0xff); } }
#else
                Y[yrow * DM + 1024 + h * 256 + v] = (bf16_t)(cvt_pk_bf16(val, val) & 0xffffu); } }
#endif
        }
    }
    __syncthreads();
}

__device__ __forceinline__ void p8_phase(const Args& a, Frame& F) {
    using att::crow;
    const float* X1 = (const float*)(F.ws + WS_X1); const float* mod = (const float*)(F.ws + WS_MOD);
    const float* wrs = (const float*)(F.ws + WS_WRS);
    unsigned char* H2 = F.ws + WS_H;
    int* TOKE = (int*)(F.ws + WS_TOKE); int* TOKP = (int*)(F.ws + WS_TOKP); float* TOKW = (float*)(F.ws + WS_TOKW); int* LIST = (int*)(F.ws + WS_LIST);
    unsigned* ctl = (unsigned*)(F.ws + WS_CTL);
    LAS float* PL = (LAS float*)F.lds;
    LAS float* PSS = (LAS float*)(F.lds + 32768);
    LAS int* hist = (LAS int*)(F.lds + 32768 + 2048);
    LAS int* basee = hist + 32;
    LAS float* rstd_l = (LAS float*)(hist + 64);
    LAS int* selE = hist + 96; LAS int* selR = hist + 96 + 128; LAS float* selW = (LAS float*)(hist + 96 + 256);
    const int r32 = F.lane & 31, hi = F.lane >> 5;
    for (int blk = F.vcu; blk < NLAT / 32; blk += F.G) {
        const int tok0 = blk * 32, b = tok0 >> 12;
        const float* Wp = wrs + (size_t)b * 65536; const float* cb = wrs + 2 * 65536 + b * 32;
        __syncthreads();
        if (F.tid < 32) hist[F.tid] = 0;
        { const int k0 = 256 * F.wave; f32x16 acc = {}; float ssq = 0.f;
          const float* xr = X1 + (size_t)(tok0 + r32) * DM + k0 + 4 * hi;
#pragma unroll 4
          for (int q = 0; q < 32; ++q) { const f32x4 a4 = *(const f32x4*)(xr + 8 * q); const float* wq_ = Wp + (size_t)(k0 + 8 * q + 4 * hi) * 32 + r32;
              const float b0 = wq_[0], b1 = wq_[32], b2 = wq_[64], b3 = wq_[96];
              ssq += (a4.x * a4.x + a4.y * a4.y) + (a4.z * a4.z + a4.w * a4.w);
              acc = __builtin_amdgcn_mfma_f32_32x32x2f32(a4.x, b0, acc, 0, 0, 0); acc = __builtin_amdgcn_mfma_f32_32x32x2f32(a4.y, b1, acc, 0, 0, 0);
              acc = __builtin_amdgcn_mfma_f32_32x32x2f32(a4.z, b2, acc, 0, 0, 0); acc = __builtin_amdgcn_mfma_f32_32x32x2f32(a4.w, b3, acc, 0, 0, 0); }
#pragma unroll
          for (int rr = 0; rr < 16; ++rr) PL[(F.wave * 32 + crow(rr, hi)) * 32 + r32] = acc[rr];
          PSS[F.wave * 64 + F.lane] = ssq; }
        __syncthreads();
#pragma unroll 1
        for (int st = 0; st < 2; ++st) { const int row = 4 * F.wave + 2 * st + hi; float sum = 0.f, ss = 0.f;
#pragma unroll
            for (int ww = 0; ww < 8; ++ww) { sum += PL[(ww * 32 + row) * 32 + r32]; ss += PSS[ww * 64 + row] + PSS[ww * 64 + 32 + row]; }
            const float rstd = 1.0f / sqrtf(ss * (1.0f / DM) + EPS);
            float v = rstd * sum + cb[r32];
            float vals[4]; int ids[4];
#pragma unroll
            for (int k = 0; k < 4; ++k) { float m = v;
#pragma unroll
                for (int o = 1; o < 32; o <<= 1) m = fmaxf(m, __shfl_xor(m, o));
                const unsigned long long bal = __ballot(v == m); const unsigned half = (unsigned)(bal >> (32 * hi)); const int idx = (int)__builtin_ctz(half) & 31;
                vals[k] = m; ids[k] = idx; if (r32 == idx) v = -3.0e38f; }
            const float e1 = __expf(vals[1] - vals[0]), e2 = __expf(vals[2] - vals[0]), e3 = __expf(vals[3] - vals[0]); const float inv = 1.0f / (1.0f + e1 + e2 + e3);
            if (r32 < 4) { const int myid = r32 == 0 ? ids[0] : r32 == 1 ? ids[1] : r32 == 2 ? ids[2] : ids[3];
                const float myw = (r32 == 0 ? 1.0f : r32 == 1 ? e1 : r32 == 2 ? e2 : e3) * inv;
                const int rank = __hip_atomic_fetch_add(&hist[myid], 1, __ATOMIC_RELAXED, __HIP_MEMORY_SCOPE_WORKGROUP);
                selE[row * 4 + r32] = myid; selR[row * 4 + r32] = rank; selW[row * 4 + r32] = myw; }
            if (r32 == 0) rstd_l[row] = rstd; }
        __syncthreads();
        if (F.tid < 32) basee[F.tid] = (int)__hip_atomic_fetch_add(ctl + CW_CNT + 64 * F.tid, (unsigned)hist[F.tid], __ATOMIC_RELAXED, __HIP_MEMORY_SCOPE_AGENT);
        __syncthreads();
        if (F.tid < 128) { const int row = F.tid >> 2; const int e = selE[F.tid]; const int pos = basee[e] + selR[F.tid]; const int tok = tok0 + row;
            LIST[e * 8192 + pos] = tok; TOKE[tok * 4 + (F.tid & 3)] = e; TOKP[tok * 4 + (F.tid & 3)] = pos; TOKW[tok * 4 + (F.tid & 3)] = selW[F.tid]; }
        const float* mrow = mod + (size_t)b * 12288;
        { f32x4 gm[8], shv[8], xa[8], xb[8];
          { f32x4 scv[8];
#pragma unroll
            for (int j = 0; j < 8; ++j) { const int k = 4 * F.lane + 256 * j; gm[j] = *(const f32x4*)(a.in[I_GN2] + k); scv[j] = *(const f32x4*)(mrow + 8192 + k); shv[j] = *(const f32x4*)(mrow + 6144 + k); }
#pragma unroll
            for (int j = 0; j < 8; ++j) gm[j] = gm[j] * (scv[j] + 1.0f); }
#pragma unroll 1
          for (int pr = 0; pr < 2; ++pr) { const int rowa = 4 * F.wave + 2 * pr, toka = tok0 + rowa; const float rsa = rstd_l[rowa], rsb = rstd_l[rowa + 1];
#pragma unroll
            for (int j = 0; j < 8; ++j) { const int k = 4 * F.lane + 256 * j; xa[j] = *(const f32x4*)(X1 + (size_t)toka * DM + k); xb[j] = *(const f32x4*)(X1 + (size_t)(toka + 1) * DM + k); }
            __builtin_amdgcn_sched_barrier(0);
#pragma unroll
            for (int j = 0; j < 8; ++j) { const int k = 4 * F.lane + 256 * j;
                const f32x4 ha = xa[j] * rsa * gm[j] + shv[j], hb = xb[j] * rsb * gm[j] + shv[j];
                int wa = 0, wb = 0; wa = __builtin_amdgcn_cvt_pk_fp8_f32(ha.x, ha.y, wa, false); wa = __builtin_amdgcn_cvt_pk_fp8_f32(ha.z, ha.w, wa, true);
                wb = __builtin_amdgcn_cvt_pk_fp8_f32(hb.x, hb.y, wb, false); wb = __builtin_amdgcn_cvt_pk_fp8_f32(hb.z, hb.w, wb, true);
                *(int*)(H2 + (size_t)toka * DM + k) = wa; *(int*)(H2 + (size_t)(toka + 1) * DM + k) = wb; } } }
    }
    __syncthreads();
}

__device__ __forceinline__ void build_etab(Frame& F) {
    unsigned* ctl = (unsigned*)(F.ws + WS_CTL); LAS int* et = (LAS int*)(F.lds + ETAB_OFF);
    __syncthreads();
    if (F.wave == 0) { const int e = F.lane & 31; const int cnt = (int)__hip_atomic_load(ctl + CW_CNT + 64 * e, __ATOMIC_RELAXED, __HIP_MEMORY_SCOPE_AGENT); const int tiles = (cnt + 255) >> 8;
        int incl = tiles;
#pragma unroll
        for (int o = 1; o < 32; o <<= 1) { const int t = __shfl_up(incl, o); if (e >= o) incl += t; }
        const unsigned long long nzm = __ballot(tiles > 0 && F.lane < 32);
        if (F.lane < 32) { et[e] = cnt; et[32 + e] = tiles; et[64 + e] = incl - tiles; if (e == 31) et[64 + 32] = incl;
            const int rk = __builtin_popcountll(nzm & ((1ull << e) - 1ull)); et[128 + e] = rk; if (tiles > 0) et[160 + rk] = e; if (e == 0) et[192] = __builtin_popcountll(nzm); } }
    __syncthreads();
}
__device__ __forceinline__ void cvt_w2_item(const Args& a, unsigned char* ws, int g, int lane) {
    const int e = g >> 10, it = g & 1023;
    cvt_item8<false>(a.in[I_W2] + (size_t)e * 2048 * 2048, 2048, ws + WS_W2T + (size_t)e * 2048 * 2048, it >> 6, 32 * (it & 63), lane);
}
__device__ __forceinline__ void moe_converter(const Args& a, Frame& F, int cw, int ncw, int w2_done) {
    LAS const int* et = (LAS const int*)(F.lds + ETAB_OFF); LAS int* xt = (LAS int*)F.lds;
    unsigned* ctl = (unsigned*)(F.ws + WS_CTL);
    if (F.wave == 0) {
        const int x = F.lane & 7; const int nunits = et[64 + 32] * 16; const int q = nunits / 8, r = nunits % 8;
        const int start = x < r ? x * (q + 1) : r * (q + 1) + (x - r) * q, len = x < r ? q + 1 : q;
        int dlo = 0, dhi = -1;
        if (len > 0) {
#pragma unroll 1
            for (int which = 0; which < 2; ++which) { const int wg = which ? start + len - 1 : start; int e = 0;
                for (int ee = 0; ee < 32; ++ee) if (et[32 + ee] > 0 && et[64 + ee] * 16 <= wg) e = ee;
                const int d = et[128 + e] * 16 + (wg - et[64 + e] * 16) / et[32 + e]; if (which) dhi = d; else dlo = d; } }
        const int dlo_next = __shfl(dlo, (F.lane + 1) & 63), len_next = __shfl(len, (F.lane + 1) & 63);
        if (x < 7 && len > 0 && len_next > 0 && dhi == dlo_next) dhi -= 1;
        const int n = dhi - dlo + 1 > 0 ? dhi - dlo + 1 : 0; int mx = n;
#pragma unroll
        for (int o = 1; o < 8; o <<= 1) mx = max(mx, __shfl_xor(mx, o));
        if (F.lane < 8) { xt[x] = dlo; xt[8 + x] = n; if (x == 0) xt[16] = mx; } }
    __syncthreads();
    const int rmax = __builtin_amdgcn_readfirstlane(xt[16]);
    for (int g = cw; g < rmax * 8 * 128; g += ncw) {
        const int t = g >> 7, sub = g & 127, x = t & 7, r = t >> 3;
        if (r >= __builtin_amdgcn_readfirstlane(xt[8 + x])) continue;
        const int d = __builtin_amdgcn_readfirstlane(xt[x]) + r, e = __builtin_amdgcn_readfirstlane(et[160 + (d >> 4)]), nt = d & 15, kb = sub >> 3, nbl = sub & 7;
        const int n0 = nbl < 4 ? nt * 128 + 32 * nbl : 2048 + nt * 128 + 32 * (nbl - 4);
        cvt_item8<true>(a.in[I_W1] + (size_t)e * 2048 * 4096, 4096, F.ws + WS_W1T + (size_t)e * 4096 * 2048, kb, n0, F.lane);
        asm volatile("s_waitcnt vmcnt(0)" ::: "memory");
        if (F.lane == 0) __hip_atomic_fetch_add(ctl + CW_FLAG + 64 * (e * 16 + nt), 1u, __ATOMIC_RELAXED, __HIP_MEMORY_SCOPE_AGENT);
    }
    for (int g = w2_done + cw; g < 32 * 16 * 64; g += ncw) cvt_w2_item(a, F.ws, g, F.lane);
}

__device__ __forceinline__ void p11_phase(const Args& a, Frame& F) {
    const float* X1 = (const float*)(F.ws + WS_X1); const float* mod = (const float*)(F.ws + WS_MOD); const bf16_t* YB = (const bf16_t*)(F.ws + WS_YB);
    const int* TOKE = (const int*)(F.ws + WS_TOKE); const int* TOKP = (const int*)(F.ws + WS_TOKP); const float* TOKW = (const float*)(F.ws + WS_TOKW);
    LAS const int* et = (LAS const int*)(F.lds + ETAB_OFF);
    build_etab(F);
    const int gw = F.vcu * NWAVES + F.wave, NGW = F.G * NWAVES;
    for (int tok = gw; tok < NLAT; tok += NGW) {
        const int b = tok >> 12; const float* gt2 = mod + (size_t)b * 12288 + 10240;
        const bf16_t* yr[4]; float w[4];
#pragma unroll
        for (int k = 0; k < 4; ++k) { const int e = TOKE[tok * 4 + k]; const int prow = et[64 + e] * 256 + TOKP[tok * 4 + k]; yr[k] = YB_FP8 ? (const bf16_t*)((const unsigned char*)YB + (size_t)prow * DM) : YB + (size_t)prow * DM; w[k] = TOKW[tok * 4 + k]; }
        f32x4 x2[8], gv[8]; u32x2 yv[4][8]; float ss = 0.f;
#pragma unroll
        for (int j = 0; j < 8; ++j) { const int kk = 4 * F.lane + 256 * j;
#pragma unroll
#if YB_FP8
            for (int k = 0; k < 4; ++k) { yv[k][j].x = *(const unsigned*)((const unsigned char*)yr[k] + kk); yv[k][j].y = 0u; }
#else
            for (int k = 0; k < 4; ++k) yv[k][j] = *(const u32x2*)(yr[k] + kk);
#endif
            x2[j] = *(const f32x4*)(X1 + (size_t)tok * DM + kk); gv[j] = *(const f32x4*)(gt2 + kk); }
        __builtin_amdgcn_sched_barrier(0);
#pragma unroll
        for (int j = 0; j < 8; ++j) { f32x4 s = {0.f, 0.f, 0.f, 0.f};
#pragma unroll
#if YB_FP8
            for (int k = 0; k < 4; ++k) { const unsigned y = yv[k][j].x; const f32x2 lo = __builtin_amdgcn_cvt_pk_f32_fp8((int)y, false), hi2 = __builtin_amdgcn_cvt_pk_f32_fp8((int)y, true);
                s.x += w[k] * lo.x; s.y += w[k] * lo.y; s.z += w[k] * hi2.x; s.w += w[k] * hi2.y; }
#else
            for (int k = 0; k < 4; ++k) { const u32x2 y = yv[k][j]; s.x += w[k] * bflo(y.x); s.y += w[k] * bfhi(y.x); s.z += w[k] * bflo(y.y); s.w += w[k] * bfhi(y.y); }
#endif
            x2[j] = x2[j] + gv[j] * s;
            ss += (x2[j].x * x2[j].x + x2[j].y * x2[j].y) + (x2[j].z * x2[j].z + x2[j].w * x2[j].w); }
        const float rstd = 1.0f / sqrtf(wave_sum(ss) * (1.0f / DM) + EPS);
#pragma unroll
        for (int j = 0; j < 8; ++j) { const int kk = 4 * F.lane + 256 * j; *(f32x4*)(a.out + (size_t)tok * DM + kk) = x2[j] * rstd * *(const f32x4*)(a.in[I_GF] + kk); }
    }
}

constexpr int NPHASE = 12;
#ifndef DUP_PHASE
#define DUP_PHASE -1
#endif
__device__ __forceinline__ void vt8_producer(Frame& F) {
    const bf16_t* P = (const bf16_t*)(F.ws + WS_P); unsigned char* VT = F.ws + WS_VT8;
    const int dl = F.lane & 31, part = F.lane >> 5;
    for (int it = F.vcu * NWAVES + F.wave; it < NB * KVH * (ROWS_B / 64) * 4; it += F.G * NWAVES) {
        const int dq = it & 3, t = it >> 2, kt = t % (ROWS_B / 64), bk = t / (ROWS_B / 64), b = bk >> 1, kvh = bk & 1, d = dq * 32 + dl;
        const bf16_t* src = P + ((size_t)b * ROWS_B + kt * 64) * PW + C_V + kvh * 128 + d;
        unsigned short v[32];
#pragma unroll
        for (int j = 0; j < 32; ++j) { const int key = j < 16 ? att::crow(j, part) : 32 + att::crow(j - 16, part); v[j] = src[(size_t)key * PW]; }
        __builtin_amdgcn_sched_barrier(0);
        int w[8];
#pragma unroll
        for (int q = 0; q < 8; ++q) { int x = 0; x = __builtin_amdgcn_cvt_pk_fp8_f32(bf2f(v[4 * q]), bf2f(v[4 * q + 1]), x, false); x = __builtin_amdgcn_cvt_pk_fp8_f32(bf2f(v[4 * q + 2]), bf2f(v[4 * q + 3]), x, true); w[q] = x; }
        unsigned char* dst = VT + ((size_t)t * 128 + d) * 64 + part * 32;
        *(u32x4*)dst = (u32x4){(unsigned)w[0], (unsigned)w[1], (unsigned)w[2], (unsigned)w[3]}; *(u32x4*)(dst + 16) = (u32x4){(unsigned)w[4], (unsigned)w[5], (unsigned)w[6], (unsigned)w[7]};
    }
}
#if ATTN_PROJ8
constexpr int W2_TAILA_Q = 56;
__device__ __forceinline__ int w2_tailA_first_idle(int G) { return G == 256 ? 204 : G; }
__device__ __forceinline__ int w2_tail_first_idle(int G) { return G == 256 ? 186 : G; }
__device__ __forceinline__ int w2_tailA_done(int G) { return (G - w2_tailA_first_idle(G)) * W2_TAILA_Q; }
__device__ __forceinline__ int w2_tail_done2(int G) { return w2_tailA_done(G) + (G - w2_tail_first_idle(G)) * W2_TAIL_Q; }
__device__ __forceinline__ int w2_tail_done(int G) { return w2_tail_done2(G) + G * W2_P5_Q; }
#else
__device__ __forceinline__ int w2_tail_first_idle(int G) { const int n3 = 646 - 2 * G; return (n3 > 0 && n3 < G) ? n3 : G; }
__device__ __forceinline__ int w2_tailA_done(int G) { return 0; }
__device__ __forceinline__ int w2_tail_done2(int G) { return (G - w2_tail_first_idle(G)) * W2_TAIL_Q; }
__device__ __forceinline__ int w2_tail_done(int G) { return w2_tail_done2(G) + G * W2_P5_Q; }
#endif
template <int PH> __device__ __forceinline__ void run_phase(const Args& args, Frame& F) {
    { int t_ = threadIdx.x; asm volatile("" : "+v"(t_)); F.tid = t_; F.lane = t_ & 63; }
    if constexpr (PH == 0) p0_phase(args, F);
    if constexpr (PH == 1) p1_phase(args, F);
    if constexpr (PH == 2) {
#if INPROJ_FP8 || PROJ_FP8
        gx::PlainSched S; S.init(F.ws + WS_H, F.ws + WS_WINT, MROWS, PW + 256, DM, F.G, (int)blockIdx.x);
        __syncthreads(); S.build_tables(F.lds); __syncthreads();
        gx::EpiInProj E{(bf16_t*)(F.ws + WS_P), (float*)(F.ws + WS_GATE), args.in[I_BIN], 1.0f / 64.0f};
        gx::gemm_run<gx::EpiInProj, gx::PlainSched, true>(F.lds, S, E, DM / 128, DM / 2, DM);
#else
#if ATTN_PROJ8
        {
            gx::PlainSched S8; S8.init(F.ws + WS_H8, F.ws + WS_WIN8, MROWS, 1536, DM, F.G, (int)blockIdx.x);
            __syncthreads(); S8.build_tables(F.lds); __syncthreads();
            gx::EpiInProj E8{(bf16_t*)(F.ws + WS_P), (float*)(F.ws + WS_GATE), args.in[I_BIN], 1.0f / 64.0f};
            gx::gemm_run<gx::EpiInProj, gx::PlainSched, true>(F.lds, S8, E8, DM / 128, DM / 2, DM);
            const int fa = w2_tailA_first_idle(F.G); const int bx = (int)blockIdx.x;
            if (bx >= fa) { const int base = (bx - fa) * W2_TAILA_Q; for (int q = F.wave; q < W2_TAILA_Q; q += NWAVES) cvt_w2_item(args, F.ws, base + q, F.lane); }
        }
        gx::PlainSched S; S.init(F.ws + WS_H, F.ws + WS_WINT + (size_t)1536 * DM * 2, MROWS, PW + 256 - 1536, DM * 2, F.G, (int)blockIdx.x); S.pn_off = 6;
#else
        gx::PlainSched S; S.init(F.ws + WS_H, F.ws + WS_WINT, MROWS, PW + 256, DM * 2, F.G, (int)blockIdx.x);
#endif
        __syncthreads(); S.build_tables(F.lds); __syncthreads();
        gx::EpiInProj E{(bf16_t*)(F.ws + WS_P), (float*)(F.ws + WS_GATE), args.in[I_BIN], 1.0f};
        gx::gemm_run(F.lds, S, E, DM / 64, DM, DM * 2);
#endif
        { const int fi = w2_tail_first_idle(F.G); const int bx = (int)blockIdx.x;
          if (bx >= fi) { const int base = w2_tailA_done(F.G) + (bx - fi) * W2_TAIL_Q; for (int q = F.wave; q < W2_TAIL_Q; q += NWAVES) cvt_w2_item(args, F.ws, base + q, F.lane); } }
    }
    if constexpr (PH == 3) { p3_phase(args, F);
#if ATT_QK8 && ATT_PV8
        vt8_producer(F);
#endif
        p4_phase(args, F); }
    if constexpr (PH == 4) { }
    if constexpr (PH == 5) { p5_phase(args, F);
        const int base = w2_tail_done2(F.G) + F.vcu * W2_P5_Q; for (int q = F.wave; q < W2_P5_Q; q += NWAVES) cvt_w2_item(args, F.ws, base + q, F.lane); }
    if constexpr (PH == 6) {
#ifndef NO_ATT
        p6_attention(args, F);
#endif
#ifndef NO_MOUT
        p6_mlstm_out(args, F);
#endif
    }
    if constexpr (PH == 7) {
#if PROJ_FP8
        gx::PlainSched S; S.init(F.ws + WS_Y, F.ws + WS_WOUTT, NLAT, DM, DM, F.G, (int)blockIdx.x);
        __syncthreads(); S.build_tables(F.lds); __syncthreads();
        gx::EpiOutProj E{args.in[I_X], (float*)(F.ws + WS_X1), (const float*)(F.ws + WS_MOD), 1.0f / 64.0f};
        gx::gemm_run<gx::EpiOutProj, gx::PlainSched, true>(F.lds, S, E, DM / 128, DM / 2, DM);
#else
        gx::PlainSched S; S.init(F.ws + WS_Y, F.ws + WS_WOUTT, NLAT, DM, DM * 2, F.G, (int)blockIdx.x);
        __syncthreads(); S.build_tables(F.lds); __syncthreads();
        gx::EpiOutProj E{args.in[I_X], (float*)(F.ws + WS_X1), (const float*)(F.ws + WS_MOD), 1.0f};
        gx::gemm_run(F.lds, S, E, DM / 64, DM, DM * 2);
#endif
    }
    if constexpr (PH == 8) p8_phase(args, F);
    if constexpr (PH == 9) {
        build_etab(F);
        unsigned* ctl9 = (unsigned*)(F.ws + WS_CTL);
        int cpx = 0; const int n8 = F.G / 8;
        if (F.G == 256) { const int nun = __builtin_amdgcn_readfirstlane(((LAS const int*)(F.lds + ETAB_OFF))[64 + 32]) * 16; float best = 3.0e38f;
#pragma unroll
            for (int c = CPX - 2; c <= CPX + 2; ++c) { const int gq = (32 - c) * 8; const float tg = 27.5f * (float)((nun + gq - 1) / gq), tc = 424.0f * 14.0f / (float)c, tm = tg > tc ? tg : tc;
                if (tm < best) { best = tm; cpx = c; } } }
        else cpx = (F.G % 8 == 0 && n8 > CPX) ? CPX : 0;
        const int xl = (int)blockIdx.x & 7, jx = (int)blockIdx.x >> 3;
        if (cpx > 0 && jx < cpx) moe_converter(args, F, (jx * 8 + xl) * NWAVES + F.wave, cpx * 8 * NWAVES, w2_tail_done(F.G));
        else {
            gx::MoeSched<16, true> S;
            if (cpx > 0) S.init(F.ws + WS_H, F.ws + WS_W1T, F.lds, (n8 - cpx) * 8, (jx - cpx) * 8 + xl, (const int*)(F.ws + WS_LIST), ctl9 + CW_FLAG, ctl9 + CW_TMO);
            else {
                for (int g = (int)blockIdx.x * NWAVES + F.wave; g < 32 * 16 * 128; g += F.G * NWAVES) { const int e = g >> 11, it = g & 2047; cvt_item8<false>(args.in[I_W1] + (size_t)e * 2048 * 4096, 4096, F.ws + WS_W1T + (size_t)e * 4096 * 2048, it >> 7, 32 * (it & 127), F.lane); }
                for (int g = (int)blockIdx.x * NWAVES + F.wave; g < 32 * 16 * 64; g += F.G * NWAVES) { const int e = g >> 10, it = g & 1023; cvt_item8<false>(args.in[I_W2] + (size_t)e * 2048 * 2048, 2048, F.ws + WS_W2T + (size_t)e * 2048 * 2048, it >> 6, 32 * (it & 63), F.lane); }
                S.init(F.ws + WS_H, F.ws + WS_W1T, F.lds, F.G, (int)blockIdx.x, (const int*)(F.ws + WS_LIST)); }
            S.build_tables(F.lds); __syncthreads();
            gx::EpiMoe1 E{F.ws + WS_ACT, args.in[I_B1], 1.0f / 64.0f};
            gx::gemm_run<gx::EpiMoe1, gx::MoeSched<16, true>, true>(F.lds, S, E, DM / 128, DM / 2, DM);
        }
    }
    if constexpr (PH == 10) {
        build_etab(F);
        gx::MoeSched<8, false> S; S.init(F.ws + WS_ACT, F.ws + WS_W2T, F.lds, F.G, (int)blockIdx.x, nullptr);
        S.build_tables(F.lds); __syncthreads();
#if YB_FP8
        gx::EpiF8Bias E{F.ws + WS_YB, DM, args.in[I_B2], DM, 1.0f / 64.0f};
        gx::gemm_run<gx::EpiF8Bias, gx::MoeSched<8, false>, true>(F.lds, S, E, DFF / 128, DFF / 2, DFF);
#else
        gx::EpiBf16Bias E{(bf16_t*)(F.ws + WS_YB), DM, args.in[I_B2], DM, 1.0f / 64.0f};
        gx::gemm_run<gx::EpiBf16Bias, gx::MoeSched<8, false>, true>(F.lds, S, E, DFF / 128, DFF / 2, DFF);
#endif
    }
    if constexpr (PH == 11) p11_phase(args, F);
}
__global__ void __launch_bounds__(NTHR, 2) mk_fwd(Args args) {
    extern __shared__ __attribute__((aligned(16))) unsigned char lds[];
    Frame F;
    F.lds = (LAS unsigned char*)lds; F.ldsg = (char*)lds;
    F.tid = threadIdx.x; F.lane = F.tid & 63; F.wave = __builtin_amdgcn_readfirstlane(F.tid >> 6);
    F.G = gridDim.x; { const int bx = blockIdx.x; F.vcu = (F.G % 8 == 0) ? (bx % 8) * (F.G / 8) + bx / 8 : bx; }
    F.ws = args.ws;
    volatile LAS unsigned* MISC = (volatile LAS unsigned*)(F.lds + MISC_OFF);
    if (F.tid < 64) MISC[F.tid] = 0u;
    __syncthreads();
    unsigned* ctl = (unsigned*)(F.ws + WS_CTL);
    XcdBarrier bar; bar.bar = ctl + CW_BAR; bar.x = 0; bar.st = nullptr;
    const int lo = args.ph_lo, hi = args.ph_hi;
    if (hi - lo > 1) bar = xcd_barrier_post(ctl + CW_BAR, MISC + 8);
#ifndef ONLY_PHASE
#define ONLY_PHASE -1
#endif
#define IN(k) ((ONLY_PHASE < 0 || ONLY_PHASE == (k)) && lo <= (k) && (k) < hi)
#ifndef TIME_PHASE
#define TIME_PHASE -1
#endif
#define DO_PHASE(k) do { if (TIME_PHASE == (k) && blockIdx.x == 0 && F.tid == 0) { const unsigned long long t_ = __builtin_amdgcn_s_memrealtime(); MISC[16] = (unsigned)t_; } \
                         if (IN(k)) { run_phase<k>(args, F); if (DUP_PHASE == (k)) { xcd_barrier(bar); run_phase<k>(args, F); } } \
                         if (IN(k) && IN((k) + 1)) xcd_barrier(bar); \
                         if (TIME_PHASE == (k) && blockIdx.x == 0 && threadIdx.x == 0) { const unsigned long long t_ = __builtin_amdgcn_s_memrealtime(); MISC[17] = (unsigned)t_ - MISC[16]; } } while (0)
    DO_PHASE(0); DO_PHASE(1); DO_PHASE(2); DO_PHASE(3);   DO_PHASE(5);
    DO_PHASE(6); DO_PHASE(7); DO_PHASE(8); DO_PHASE(9); DO_PHASE(10); DO_PHASE(11);
    if (TIME_PHASE >= 0 && blockIdx.x == 0 && threadIdx.x == 0) { const unsigned dt = MISC[17]; const unsigned long long t0_ = __builtin_amdgcn_s_memrealtime();
        while ((unsigned)(__builtin_amdgcn_s_memrealtime() - t0_) < 4u * dt) __builtin_amdgcn_s_sleep(8); }
#undef IN
#undef DO_PHASE
}

extern "C" void kernel_launch(void* const* d_in, const int* in_sizes, int n_in, void* d_out, int out_size, void* d_ws, size_t ws_size, hipStream_t stream) {
    static int grid = 0;
    if (grid == 0) {
        if (n_in != 21 || out_size != NLAT * DM || ws_size < WS_END) { fprintf(stderr, "kernel_launch: unexpected shapes (n_in %d out %d ws %zu)\n", n_in, out_size, ws_size); grid = -1; return; }
        int dev = 0, cus = 0, per_cu = 0;
        if (hipGetDevice(&dev) != hipSuccess || hipDeviceGetAttribute(&cus, hipDeviceAttributeMultiprocessorCount, dev) != hipSuccess) { grid = -1; return; }
        if (hipFuncSetAttribute((const void*)mk_fwd, hipFuncAttributeMaxDynamicSharedMemorySize, LDS_BYTES) != hipSuccess) { fprintf(stderr, "kernel_launch: hipFuncSetAttribute failed\n"); grid = -1; return; }
        if (hipOccupancyMaxActiveBlocksPerMultiprocessor(&per_cu, (const void*)mk_fwd, NTHR, LDS_BYTES) != hipSuccess || per_cu < 1) { fprintf(stderr, "kernel_launch: occupancy query says %d blocks per CU\n", per_cu); (void)hipGetLastError(); grid = -1; return; }
        grid = cus;
    }
    if (grid < 0) return;
    (void)hipMemsetAsync((char*)d_ws + WS_CTL, 0, CTL_ZERO_BYTES, stream);
    Args a{};
    for (int i = 0; i < 21; ++i) a.in[i] = (const float*)d_in[i];
    a.out = (float*)d_out; a.ws = (unsigned char*)d_ws;
#if MK_ONE_LAUNCH
    a.ph_lo = 0; a.ph_hi = NPHASE;
    hipLaunchKernelGGL(mk_fwd, dim3(grid), dim3(NTHR), LDS_BYTES, stream, a);
#else
    for (int p = 0; p < NPHASE; ++p) { a.ph_lo = p; a.ph_hi = p + 1; hipLaunchKernelGGL(mk_fwd, dim3(grid), dim3(NTHR), LDS_BYTES, stream, a); }
#endif
    const hipError_t le = hipPeekAtLastError();
    if (le != hipSuccess) fprintf(stderr, "kernel_launch: launch failed: %s\n", hipGetErrorName(le));
}
```
